# Optimizing an MI355X kernel written in HIP

```python
import jax, jax.numpy as jnp
from jax import lax
import numpy as np

D_MODEL = 1024
BATCH = 1
SEQ = 16384
DEPTH = 4

HEAD_DIM = 64
A_HEADS = 8
B_HEADS = 4
C_HEADS = 4
A_WIDTH = A_HEADS * HEAD_DIM
B_WIDTH = B_HEADS * HEAD_DIM
C_WIDTH = C_HEADS * HEAD_DIM
MIX_WIDTH = A_WIDTH + B_WIDTH + C_WIDTH
MOBA_BLOCK = 256
MOBA_TOPK = 3
MOBA_QCHUNK = 128
RET_CHUNK = 256
MLSTM_CHUNK = 128
PAD_MULT = 256
CONV_K = 4
RMS_EPS = 1e-6
HEAD_NORM_EPS = 1e-5
ROPE_BASE = 10000.0
SPLIT_SIZES = [A_WIDTH] * 4 + [B_WIDTH] * 4 + [C_WIDTH] * 5 + [C_HEADS, C_HEADS]
N_IN = sum(SPLIT_SIZES)

kernel_name = "hymba_style_moba_retention_mlstm_trunk"


def rmsnorm(x, w):
    x32 = x.astype(jnp.float32)
    y = x32 * lax.rsqrt(jnp.mean(x32 * x32, axis=-1, keepdims=True) + RMS_EPS)
    return (y * w.astype(jnp.float32)).astype(x.dtype)


def split_heads(t, n_heads):
    b, s, _ = t.shape
    return t.reshape(b, s, n_heads, HEAD_DIM).transpose(0, 2, 1, 3)


def merge_heads(t):
    b, h, s, d = t.shape
    return t.transpose(0, 2, 1, 3).reshape(b, s, h * d)


def head_norm(y, w):
    mu = jnp.mean(y, axis=-1, keepdims=True)
    var = jnp.mean(jnp.square(y - mu), axis=-1, keepdims=True)
    y = (y - mu) * lax.rsqrt(var + HEAD_NORM_EPS)
    return merge_heads(y) * w.astype(jnp.float32)


def alibi_slopes(n_heads):
    return jnp.exp2(-8.0 * jnp.arange(1, n_heads + 1, dtype=jnp.float32) / n_heads)


def rotate(t, pos):
    half = t.shape[-1] // 2
    theta = 1.0 / (ROPE_BASE ** jnp.linspace(0.0, 1.0, half, dtype=jnp.float32))
    ang = pos[:, None] * theta[None, :]
    cos, sin = jnp.cos(ang), jnp.sin(ang)
    t1, t2 = t[..., :half], t[..., half:]
    return jnp.concatenate([t1 * cos - t2 * sin, t1 * sin + t2 * cos], axis=-1)


def moba_attention(q, k, v):
    b, h, s, dh = q.shape
    nb = s // MOBA_BLOCK
    n_sel = min(MOBA_TOPK, nb - 1)
    scale = dh ** -0.5
    slopes = alibi_slopes(h)[None, :, None, None]
    kb = k.reshape(b, h, nb, MOBA_BLOCK, dh)
    vb = v.reshape(b, h, nb, MOBA_BLOCK, dh)
    kmean = jnp.mean(kb, axis=3)
    bi = jnp.arange(b)[:, None, None, None]
    hi = jnp.arange(h)[None, :, None, None]
    offs = jnp.arange(MOBA_BLOCK)
    qloc = jnp.arange(MOBA_QCHUNK)

    def one_chunk(c):
        t0 = c * MOBA_QCHUNK
        qc = lax.dynamic_slice_in_dim(q, t0, MOBA_QCHUNK, axis=2)
        tpos = t0 + qloc
        j = t0 // MOBA_BLOCK
        k_own = lax.dynamic_slice_in_dim(k, j * MOBA_BLOCK, MOBA_BLOCK, axis=2)
        v_own = lax.dynamic_slice_in_dim(v, j * MOBA_BLOCK, MOBA_BLOCK, axis=2)
        dist_own = tpos[:, None] - (j * MOBA_BLOCK + offs)[None, :]
        s_own = jnp.einsum('bhqd,bhkd->bhqk', qc, k_own) * scale - slopes * dist_own
        s_own = jnp.where(dist_own >= 0, s_own, -jnp.inf)
        if n_sel == 0:
            p = jax.nn.softmax(s_own, axis=-1)
            return jnp.einsum('bhqk,bhkd->bhqd', p, v_own)
        gate = jnp.einsum('bhqd,bhnd->bhqn', qc, kmean)
        gate = jnp.where(jnp.arange(nb) < j, gate, -jnp.inf)
        _, idx = lax.top_k(gate, n_sel)
        valid = jnp.arange(n_sel) < j
        k_sel = kb[bi, hi, idx]
        v_sel = vb[bi, hi, idx]
        dist = tpos[:, None, None] - (idx[..., None] * MOBA_BLOCK + offs)
        s_sel = jnp.einsum('bhqd,bhqnkd->bhqnk', qc, k_sel) * scale - slopes[..., None] * dist
        s_sel = jnp.where(valid[:, None], s_sel, -jnp.inf)
        n_k = n_sel * MOBA_BLOCK
        s_all = jnp.concatenate([s_sel.reshape(b, h, MOBA_QCHUNK, n_k), s_own], axis=-1)
        p = jax.nn.softmax(s_all, axis=-1)
        p_sel = p[..., :n_k].reshape(b, h, MOBA_QCHUNK, n_sel, MOBA_BLOCK)
        p_own = p[..., n_k:]
        return (jnp.einsum('bhqnk,bhqnkd->bhqd', p_sel, v_sel)
                + jnp.einsum('bhqk,bhkd->bhqd', p_own, v_own))

    outs = lax.map(one_chunk, jnp.arange(s // MOBA_QCHUNK))
    return outs.transpose(1, 2, 0, 3, 4).reshape(b, h, s, dh)


def retention(q, k, v):
    b, h, s, dh = q.shape
    L = RET_CHUNK
    nc = s // L
    log_gamma = jnp.log(1.0 - jnp.exp2(-5.0 - jnp.arange(h, dtype=jnp.float32)))
    k = k * (dh ** -0.5)
    qc = q.reshape(b, h, nc, L, dh)
    kc = k.reshape(b, h, nc, L, dh)
    vc = v.reshape(b, h, nc, L, dh)
    pos = jnp.arange(L, dtype=jnp.float32)
    diff = pos[:, None] - pos[None, :]
    decay = jnp.where(diff >= 0, jnp.exp(log_gamma[:, None, None] * jnp.maximum(diff, 0.0)), 0.0)
    scores = jnp.einsum('bhcnd,bhcmd->bhcnm', qc, kc) * decay[None, :, None]
    o_intra = jnp.einsum('bhcnm,bhcme->bhcne', scores, vc)
    zeta = jnp.exp(log_gamma[:, None] * (L - 1.0 - pos))
    kv = jnp.einsum('bhcmd,bhcme->bhcde', kc * zeta[None, :, None, :, None], vc)
    chunk_decay = jnp.exp(log_gamma * L)[None, :, None, None]

    def step(state, kv_c):
        return chunk_decay * state + kv_c, state

    r0 = jnp.zeros((b, h, dh, dh), jnp.float32)
    _, r_prev = lax.scan(step, r0, kv.transpose(2, 0, 1, 3, 4))
    r_prev = r_prev.transpose(1, 2, 0, 3, 4)
    xi = jnp.exp(log_gamma[:, None] * (pos + 1.0))
    o_cross = jnp.einsum('bhcnd,bhcde->bhcne', qc, r_prev) * xi[None, :, None, :, None]
    return (o_intra + o_cross).reshape(b, h, s, dh)


def mlstm(q, k, v, i_pre, f_pre):
    b, h, s, dh = q.shape
    L = MLSTM_CHUNK
    nc = s // L
    k = k * (dh ** -0.5)
    to_chunks = lambda t: t.reshape(b, h, nc, L, dh).transpose(2, 0, 1, 3, 4)
    qc, kc, vc = to_chunks(q), to_chunks(k), to_chunks(v)
    ic = i_pre.reshape(b, h, nc, L).transpose(2, 0, 1, 3)
    bc = jnp.cumsum(jax.nn.log_sigmoid(f_pre).reshape(b, h, nc, L), axis=-1).transpose(2, 0, 1, 3)
    pos = jnp.arange(L)
    causal = pos[:, None] >= pos[None, :]

    def step(carry, inp):
        c_st, n_st, m_st = carry
        qt, kt, vt, it, bt = inp
        d_log = jnp.where(causal, bt[..., :, None] - bt[..., None, :] + it[..., None, :], -jnp.inf)
        inter_log = bt + m_st[..., None]
        m_t = jnp.maximum(inter_log, jnp.max(d_log, axis=-1))
        w_intra = jnp.exp(d_log - m_t[..., None])
        w_inter = jnp.exp(inter_log - m_t)
        sc = jnp.einsum('bhtd,bhsd->bhts', qt, kt) * w_intra
        num = (jnp.einsum('bhts,bhse->bhte', sc, vt)
               + w_inter[..., None] * jnp.einsum('bhtd,bhde->bhte', qt, c_st))
        den = jnp.sum(sc, axis=-1) + w_inter * jnp.einsum('bhtd,bhd->bht', qt, n_st)
        h_t = num / jnp.maximum(jnp.abs(den), jnp.exp(-m_t))[..., None]
        b_last = bt[..., -1]
        g = b_last[..., None] - bt + it
        m_new = jnp.maximum(b_last + m_st, jnp.max(g, axis=-1))
        a = jnp.exp(b_last + m_st - m_new)
        w = jnp.exp(g - m_new[..., None])
        c_new = a[..., None, None] * c_st + jnp.einsum('bhs,bhsd,bhse->bhde', w, kt, vt)
        n_new = a[..., None] * n_st + jnp.einsum('bhs,bhsd->bhd', w, kt)
        return (c_new, n_new, m_new), h_t

    init = (jnp.zeros((b, h, dh, dh), jnp.float32), jnp.zeros((b, h, dh), jnp.float32),
            jnp.zeros((b, h), jnp.float32))
    _, hs = lax.scan(step, init, (qc, kc, vc, ic, bc))
    return hs.transpose(1, 2, 0, 3, 4).reshape(b, h, s, dh)


def causal_dwconv(x, w, bias):
    c = x.shape[-1]
    y = lax.conv_general_dilated(x, w.astype(x.dtype)[:, None, :], window_strides=(1,),
                                 padding=[(CONV_K - 1, 0)], dimension_numbers=('NWC', 'WIO', 'NWC'),
                                 feature_group_count=c)
    return y + bias.astype(x.dtype)


def hybrid_layer(x, norm_w, w_in, conv_w, conv_b, gate_bias, ret_norm_w, mlstm_norm_w, w_out):
    b, s, _ = x.shape
    s_pad = -(-s // PAD_MULT) * PAD_MULT
    h = rmsnorm(x, norm_w)
    proj = jnp.matmul(h, w_in).astype(jnp.float32)
    proj = jnp.pad(proj, ((0, 0), (0, s_pad - s), (0, 0)))
    cuts = np.cumsum(SPLIT_SIZES)[:-1].tolist()
    (aq, ak, av, ag, bq, bk, bv, bg, cq, ck, cv, co, cg, ci, cf) = jnp.split(proj, cuts, axis=-1)

    ya = moba_attention(split_heads(aq, A_HEADS), split_heads(ak, A_HEADS), split_heads(av, A_HEADS))
    ya = merge_heads(ya) * jax.nn.silu(ag)

    pos = jnp.arange(s_pad, dtype=jnp.float32)
    yb = retention(rotate(split_heads(bq, B_HEADS), pos), rotate(split_heads(bk, B_HEADS), pos),
                   split_heads(bv, B_HEADS))
    yb = head_norm(yb, ret_norm_w) * jax.nn.silu(bg)

    qk = jax.nn.silu(causal_dwconv(jnp.concatenate([cq, ck], axis=-1), conv_w, conv_b))
    cq_c, ck_c = qk[..., :C_WIDTH], qk[..., C_WIDTH:]
    gb = gate_bias.astype(jnp.float32)
    i_pre = ci.transpose(0, 2, 1) + gb[:C_HEADS][None, :, None]
    f_pre = cf.transpose(0, 2, 1) + gb[C_HEADS:][None, :, None]
    yc = mlstm(split_heads(cq_c, C_HEADS), split_heads(ck_c, C_HEADS), split_heads(cv, C_HEADS),
               i_pre, f_pre)
    yc = yc * split_heads(jax.nn.sigmoid(co), C_HEADS)
    yc = head_norm(yc, mlstm_norm_w) * jax.nn.silu(cg)

    y = jnp.concatenate([ya, yb, yc], axis=-1)[:, :s].astype(x.dtype)
    return x + jnp.matmul(y, w_out)


def setup_inputs(seed: int = 0) -> dict:
    key = jax.random.key(seed)
    ks = jax.random.split(key, 12)
    f32 = jnp.float32
    x = jax.random.normal(ks[0], (BATCH, SEQ, D_MODEL), f32)
    norm_w = 1.0 + 0.02 * jax.random.normal(ks[1], (DEPTH, D_MODEL), f32)
    w_in = jax.random.normal(ks[2], (DEPTH, D_MODEL, N_IN), f32) * D_MODEL ** -0.5
    conv_w = jax.random.normal(ks[3], (DEPTH, CONV_K, 2 * C_WIDTH), f32) * CONV_K ** -0.5
    conv_b = 0.02 * jax.random.normal(ks[4], (DEPTH, 2 * C_WIDTH), f32)
    i_bias = 0.1 * jax.random.normal(ks[5], (DEPTH, C_HEADS), f32)
    f_bias = jnp.linspace(3.0, 6.0, C_HEADS, dtype=f32)[None, :] + 0.1 * jax.random.normal(ks[6], (DEPTH, C_HEADS), f32)
    gate_bias = jnp.concatenate([i_bias, f_bias], axis=-1)
    ret_norm_w = 1.0 + 0.02 * jax.random.normal(ks[7], (DEPTH, B_WIDTH), f32)
    mlstm_norm_w = 1.0 + 0.02 * jax.random.normal(ks[8], (DEPTH, C_WIDTH), f32)
    w_out = jax.random.normal(ks[9], (DEPTH, MIX_WIDTH, D_MODEL), f32) * MIX_WIDTH ** -0.5
    final_norm_w = 1.0 + 0.02 * jax.random.normal(ks[10], (D_MODEL,), f32)
    return {"x": x, "norm_w": norm_w, "w_in": w_in, "conv_w": conv_w, "conv_b": conv_b,
            "gate_bias": gate_bias, "ret_norm_w": ret_norm_w, "mlstm_norm_w": mlstm_norm_w,
            "w_out": w_out, "final_norm_w": final_norm_w}


def reference(x, norm_w, w_in, conv_w, conv_b, gate_bias, ret_norm_w, mlstm_norm_w, w_out, final_norm_w):
    for layer in range(DEPTH):
        x = hybrid_layer(x, norm_w[layer], w_in[layer], conv_w[layer], conv_b[layer], gate_bias[layer],
                         ret_norm_w[layer], mlstm_norm_w[layer], w_out[layer])
    return rmsnorm(x, final_norm_w)
```

```cpp
#include <hip/hip_runtime.h>
#include <stdint.h>

#define SEQ 16384
#define DM 1024
#define DEPTH 4
#define NIN 4360
#define NP 4352
#define MIXW 1024
#define C_AQ 0
#define C_AK 512
#define C_AV 1024
#define C_AG 1536
#define C_BQ 2048
#define C_BK 2304
#define C_BV 2560
#define C_BG 2816
#define C_CQ 3072
#define C_CK 3328
#define C_CV 3584
#define C_CO 3840
#define C_CG 4096

typedef unsigned short bf16_t;
__device__ __forceinline__ float bf2f(bf16_t b) { return __uint_as_float(((unsigned)b) << 16); }
__device__ __forceinline__ bf16_t f2bf(float f) { unsigned u = __float_as_uint(f); u += 0x7FFFu + ((u >> 16) & 1u); return (bf16_t)(u >> 16); }
__device__ __forceinline__ float siluf(float x) { return x / (1.f + __expf(-x)); }
__device__ __forceinline__ float sigmf(float x) { return 1.f / (1.f + __expf(-x)); }

__constant__ double c_theta[32] = {1, 0.74296395075949484, 0.55199543212815705, 0.41011270705513009, 0.30469895709035083, 0.22638034095214485, 0.16819243248808699, 0.12496091412919871, 0.092841454451947455, 0.06897785379387654, 0.051248058769609341, 0.038075460212223723, 0.028288694346259694, 0.021017480113324882, 0.015615230060004972, 0.011601553017399716, 0.0086195356647530315, 0.006404004271197283, 0.0047579443140094097, 0.0035349811050301057, 0.0026263635276533325, 0.0019512934226359642, 0.0014497406703726315, 0.0010771050560367691, 0.00080025022781610535, 0.0005945570708544394, 0.00044173447031400687, 0.0003281927872511474, 0.00024383540982688293, 0.00018116091942004152, 0.00013459603241553644, 0.0001};

__global__ void k_rope_table(float2* tab) {
    int i = blockIdx.x * blockDim.x + threadIdx.x;
    if (i >= SEQ * 32) return;
    int pos = i >> 5, f = i & 31;
    double a = (double)pos * c_theta[f];
    double k = rint(a * 0.63661977236758134308);
    double r = a - k * 1.57079632679489661923;
    r -= k * 6.123233995736766e-17;
    double r2 = r * r;
    double s = r * (1.0 + r2 * (-1.0 / 6 + r2 * (1.0 / 120 + r2 * (-1.0 / 5040 + r2 * (1.0 / 362880 + r2 * (-1.0 / 39916800 + r2 * (1.0 / 6227020800.0)))))));
    double c = 1.0 + r2 * (-0.5 + r2 * (1.0 / 24 + r2 * (-1.0 / 720 + r2 * (1.0 / 40320 + r2 * (-1.0 / 3628800 + r2 * (1.0 / 479001600.0 + r2 * (-1.0 / 87178291200.0)))))));
    long long kq = (long long)k; int q = (int)(kq & 3);
    double cs, sn;
    if (q == 0) { cs = c; sn = s; } else if (q == 1) { cs = -s; sn = c; } else if (q == 2) { cs = -c; sn = -s; } else { cs = s; sn = -c; }
    tab[i] = make_float2((float)cs, (float)sn);
}

__global__ void k_copy(const float* __restrict__ src, float* __restrict__ dst, size_t n) {
    size_t i = (size_t)blockIdx.x * blockDim.x + threadIdx.x;
    for (; i < n; i += (size_t)gridDim.x * blockDim.x) dst[i] = src[i];
}

__global__ void k_rms(const float* __restrict__ x, const float* __restrict__ w, float* __restrict__ h) {
    int row = blockIdx.x * 4 + (threadIdx.x >> 6), lane = threadIdx.x & 63;
    const float* xr = x + (size_t)row * DM;
    float v[16]; float ss = 0.f;
#pragma unroll
    for (int i = 0; i < 16; ++i) { v[i] = xr[lane + 64 * i]; ss += v[i] * v[i]; }
#pragma unroll
    for (int o = 32; o > 0; o >>= 1) ss += __shfl_xor(ss, o);
    float rs = rsqrtf(ss * (1.f / DM) + 1e-6f);
#pragma unroll
    for (int i = 0; i < 16; ++i) h[(size_t)row * DM + lane + 64 * i] = v[i] * rs * w[lane + 64 * i];
}

template <int MODE>
__global__ void __launch_bounds__(256) k_gemm_simple(const void* __restrict__ Av, const float* __restrict__ B, int M, int N, int K,
                                                     bf16_t* __restrict__ proj, float* __restrict__ gates, float* __restrict__ xres) {
    __shared__ float As[16][64 + 4];
    __shared__ float Bs[16][64 + 4];
    int tx = threadIdx.x & 15, ty = threadIdx.x >> 4;
    int m0 = blockIdx.y * 64, n0 = blockIdx.x * 64;
    float acc[4][4];
#pragma unroll
    for (int i = 0; i < 4; ++i)
#pragma unroll
        for (int j = 0; j < 4; ++j) acc[i][j] = 0.f;
    for (int k0 = 0; k0 < K; k0 += 16) {
        {
            int r = threadIdx.x >> 2, c4 = (threadIdx.x & 3) * 4;
            float a0, a1, a2, a3;
            if (MODE == 0) { const float* A = (const float*)Av; const float* p = A + (size_t)(m0 + r) * K + k0 + c4; a0 = p[0]; a1 = p[1]; a2 = p[2]; a3 = p[3]; }
            else { const bf16_t* A = (const bf16_t*)Av; const bf16_t* p = A + (size_t)(m0 + r) * K + k0 + c4; a0 = bf2f(p[0]); a1 = bf2f(p[1]); a2 = bf2f(p[2]); a3 = bf2f(p[3]); }
            As[c4 + 0][r] = a0; As[c4 + 1][r] = a1; As[c4 + 2][r] = a2; As[c4 + 3][r] = a3;
        }
        {
            int r = threadIdx.x >> 4, c4 = (threadIdx.x & 15) * 4;
#pragma unroll
            for (int j = 0; j < 4; ++j) { int n = n0 + c4 + j; Bs[r][c4 + j] = (n < N) ? B[(size_t)(k0 + r) * N + n] : 0.f; }
        }
        __syncthreads();
#pragma unroll
        for (int kk = 0; kk < 16; ++kk) {
            float a[4], b[4];
#pragma unroll
            for (int i = 0; i < 4; ++i) a[i] = As[kk][ty * 4 + i];
#pragma unroll
            for (int j = 0; j < 4; ++j) b[j] = Bs[kk][tx * 4 + j];
#pragma unroll
            for (int i = 0; i < 4; ++i)
#pragma unroll
                for (int j = 0; j < 4; ++j) acc[i][j] = fmaf(a[i], b[j], acc[i][j]);
        }
        __syncthreads();
    }
#pragma unroll
    for (int i = 0; i < 4; ++i)
#pragma unroll
        for (int j = 0; j < 4; ++j) {
            int m = m0 + ty * 4 + i, n = n0 + tx * 4 + j;
            if (n >= N) continue;
            if (MODE == 0) { if (n < NP) proj[(size_t)m * NP + n] = f2bf(acc[i][j]); else gates[(size_t)m * 8 + (n - NP)] = acc[i][j]; }
            else xres[(size_t)m * N + n] += acc[i][j];
        }
}

__global__ void k_kmean(const bf16_t* __restrict__ proj, float* __restrict__ kmean) {
    int n = blockIdx.x, c = threadIdx.x;
    float s = 0.f;
    for (int r = 0; r < 256; ++r) s += bf2f(proj[(size_t)(n * 256 + r) * NP + C_AK + c]);
    int h = c >> 6, d = c & 63;
    kmean[((size_t)h * 64 + n) * 64 + d] = s * (1.f / 256.f);
}

__global__ void __launch_bounds__(64) k_moba_simple(const bf16_t* __restrict__ proj, const float* __restrict__ kmean, bf16_t* __restrict__ y) {
    int h = blockIdx.y, t = blockIdx.x * 64 + threadIdx.x;
    float q[64];
    const bf16_t* qp = proj + (size_t)t * NP + C_AQ + h * 64;
#pragma unroll
    for (int d = 0; d < 64; ++d) q[d] = bf2f(qp[d]);
    int j = t >> 8;
    float g0 = -INFINITY, g1 = -INFINITY, g2 = -INFINITY; int i0 = 0, i1 = 1, i2 = 2;
    for (int n = 0; n < j; ++n) {
        const float* km = kmean + ((size_t)h * 64 + n) * 64;
        float g = 0.f;
#pragma unroll
        for (int d = 0; d < 64; ++d) g = fmaf(q[d], km[d], g);
        if (g > g0) { g2 = g1; i2 = i1; g1 = g0; i1 = i0; g0 = g; i0 = n; }
        else if (g > g1) { g2 = g1; i2 = i1; g1 = g; i1 = n; }
        else if (g > g2) { g2 = g; i2 = n; }
    }
    int nsel = j < 3 ? j : 3;
    float slope = exp2f(-(float)(h + 1));
    float m = -INFINITY, l = 0.f; float o[64];
#pragma unroll
    for (int d = 0; d < 64; ++d) o[d] = 0.f;
    for (int seg = 0; seg <= nsel; ++seg) {
        int blk, nk;
        if (seg < nsel) { blk = seg == 0 ? i0 : (seg == 1 ? i1 : i2); nk = 256; }
        else { blk = j; nk = t - j * 256 + 1; }
        for (int kk = 0; kk < nk; ++kk) {
            int kp = blk * 256 + kk;
            const bf16_t* krow = proj + (size_t)kp * NP + C_AK + h * 64;
            const bf16_t* vrow = proj + (size_t)kp * NP + C_AV + h * 64;
            float s = 0.f;
#pragma unroll
            for (int d = 0; d < 64; ++d) s = fmaf(q[d], bf2f(krow[d]), s);
            s = s * 0.125f - slope * (float)(t - kp);
            float mn = fmaxf(m, s);
            float sc = __expf(m - mn), p = __expf(s - mn);
            l = l * sc + p;
#pragma unroll
            for (int d = 0; d < 64; ++d) o[d] = fmaf(o[d], sc, p * bf2f(vrow[d]));
            m = mn;
        }
    }
    float inv = 1.f / l;
    const bf16_t* gp = proj + (size_t)t * NP + C_AG + h * 64;
#pragma unroll
    for (int d = 0; d < 64; ++d) y[(size_t)t * MIXW + h * 64 + d] = f2bf(o[d] * inv * siluf(bf2f(gp[d])));
}

__global__ void __launch_bounds__(1024) k_recur_simple(const bf16_t* __restrict__ proj, const float* __restrict__ gates, const float2* __restrict__ rope,
                                                       const float* __restrict__ conv_w, const float* __restrict__ conv_b, const float* __restrict__ gate_bias,
                                                       const float* __restrict__ ret_nw, const float* __restrict__ ml_nw, bf16_t* __restrict__ y) {
    __shared__ float red[2][17][64];
    __shared__ float sh_den[2][16];
    const int tid = threadIdx.x, e = tid & 63, dq = tid >> 6;
    const bool is_ret = blockIdx.x < 4;
    const int h = blockIdx.x & 3;
    float S[4] = {0.f, 0.f, 0.f, 0.f};
    float nst[4] = {0.f, 0.f, 0.f, 0.f};
    float mst = 0.f;
    const float gamma = 1.f - exp2f(-5.f - (float)h);
    float cw_q[4][4], cw_k[4][4], cb_q[4], cb_k[4];
    if (!is_ret) {
#pragma unroll
        for (int i = 0; i < 4; ++i) {
            int c = h * 64 + dq * 4 + i;
#pragma unroll
            for (int j = 0; j < 4; ++j) { cw_q[j][i] = conv_w[j * 512 + c]; cw_k[j][i] = conv_w[j * 512 + 256 + c]; }
            cb_q[i] = conv_b[c]; cb_k[i] = conv_b[256 + c];
        }
    }
    const float ib = is_ret ? 0.f : gate_bias[h], fb = is_ret ? 0.f : gate_bias[4 + h];
    for (int t = 0; t < SEQ; ++t) {
        const bf16_t* pr = proj + (size_t)t * NP;
        float qv[4], kv[4], ve;
        float wi = 1.f, wf = gamma;
        if (is_ret) {
#pragma unroll
            for (int i = 0; i < 4; ++i) {
                int d = dq * 4 + i; int f = d & 31;
                float2 cs = rope[t * 32 + f];
                float q1 = bf2f(pr[C_BQ + h * 64 + f]), q2 = bf2f(pr[C_BQ + h * 64 + 32 + f]);
                float k1 = bf2f(pr[C_BK + h * 64 + f]), k2 = bf2f(pr[C_BK + h * 64 + 32 + f]);
                if (d < 32) { qv[i] = q1 * cs.x - q2 * cs.y; kv[i] = k1 * cs.x - k2 * cs.y; }
                else { qv[i] = q1 * cs.y + q2 * cs.x; kv[i] = k1 * cs.y + k2 * cs.x; }
                kv[i] *= 0.125f;
            }
            ve = bf2f(pr[C_BV + h * 64 + e]);
        } else {
#pragma unroll
            for (int i = 0; i < 4; ++i) {
                int c = h * 64 + dq * 4 + i;
                float aq = cb_q[i], ak = cb_k[i];
#pragma unroll
                for (int j = 0; j < 4; ++j) {
                    int tt = t - 3 + j;
                    if (tt >= 0) { aq = fmaf(cw_q[j][i], bf2f(proj[(size_t)tt * NP + C_CQ + c]), aq); ak = fmaf(cw_k[j][i], bf2f(proj[(size_t)tt * NP + C_CK + c]), ak); }
                }
                qv[i] = siluf(aq); kv[i] = siluf(ak) * 0.125f;
            }
            ve = bf2f(pr[C_CV + h * 64 + e]);
            float ipre = gates[(size_t)t * 8 + h] + ib, fpre = gates[(size_t)t * 8 + 4 + h] + fb;
            float logf = fminf(fpre, 0.f) - log1pf(__expf(-fabsf(fpre)));
            float mnew = fmaxf(logf + mst, ipre);
            wf = __expf(logf + mst - mnew); wi = __expf(ipre - mnew); mst = mnew;
        }
        float part = 0.f, pden = 0.f;
#pragma unroll
        for (int i = 0; i < 4; ++i) {
            S[i] = wf * S[i] + wi * kv[i] * ve;
            part = fmaf(qv[i], S[i], part);
            if (!is_ret) { nst[i] = wf * nst[i] + wi * kv[i]; pden = fmaf(qv[i], nst[i], pden); }
        }
        const int pb = t & 1;
        red[pb][dq][e] = part;
        if (!is_ret && e == 0) sh_den[pb][dq] = pden;
        __syncthreads();
        if (tid < 64) {
            float o = 0.f;
#pragma unroll
            for (int g = 0; g < 16; ++g) o += red[pb][g][e];
            const bf16_t* gp;
            float nw;
            if (is_ret) { gp = pr + C_BG + h * 64 + e; nw = ret_nw[h * 64 + e]; }
            else {
                float den = 0.f;
#pragma unroll
                for (int g = 0; g < 16; ++g) den += sh_den[pb][g];
                o = o / fmaxf(fabsf(den), __expf(-mst));
                o *= sigmf(bf2f(pr[C_CO + h * 64 + e]));
                gp = pr + C_CG + h * 64 + e; nw = ml_nw[h * 64 + e];
            }
            float mu = o;
#pragma unroll
            for (int of = 32; of > 0; of >>= 1) mu += __shfl_xor(mu, of);
            mu *= (1.f / 64.f);
            float dv = o - mu, var = dv * dv;
#pragma unroll
            for (int of = 32; of > 0; of >>= 1) var += __shfl_xor(var, of);
            var *= (1.f / 64.f);
            float r = dv * rsqrtf(var + 1e-5f) * nw * siluf(bf2f(*gp));
            y[(size_t)t * MIXW + (is_ret ? 512 : 768) + h * 64 + e] = f2bf(r);
        }
    }
}

__global__ void k_final_norm(const float* __restrict__ w, float* __restrict__ xio) {
    int row = blockIdx.x * 4 + (threadIdx.x >> 6), lane = threadIdx.x & 63;
    float* xr = xio + (size_t)row * DM;
    float v[16]; float ss = 0.f;
#pragma unroll
    for (int i = 0; i < 16; ++i) { v[i] = xr[lane + 64 * i]; ss += v[i] * v[i]; }
#pragma unroll
    for (int o = 32; o > 0; o >>= 1) ss += __shfl_xor(ss, o);
    float rs = rsqrtf(ss * (1.f / DM) + 1e-6f);
#pragma unroll
    for (int i = 0; i < 16; ++i) xr[lane + 64 * i] = v[i] * rs * w[lane + 64 * i];
}

extern "C" void kernel_launch(void* const* d_in, const int* in_sizes, int n_in, void* d_out, int out_size, void* d_ws, size_t ws_size, hipStream_t stream) {
    const float* x = (const float*)d_in[0];
    const float* norm_w = (const float*)d_in[1];
    const float* w_in = (const float*)d_in[2];
    const float* conv_w = (const float*)d_in[3];
    const float* conv_b = (const float*)d_in[4];
    const float* gate_bias = (const float*)d_in[5];
    const float* ret_nw = (const float*)d_in[6];
    const float* ml_nw = (const float*)d_in[7];
    const float* w_out = (const float*)d_in[8];
    const float* final_nw = (const float*)d_in[9];
    float* xres = (float*)d_out;
    char* ws = (char*)d_ws;
    size_t off = 0;
    auto take = [&](size_t bytes) { char* p = ws + off; off += (bytes + 255) & ~(size_t)255; return p; };
    float* hbuf = (float*)take((size_t)SEQ * DM * 4);
    bf16_t* proj = (bf16_t*)take((size_t)SEQ * NP * 2);
    float* gates = (float*)take((size_t)SEQ * 8 * 4);
    bf16_t* ybuf = (bf16_t*)take((size_t)SEQ * MIXW * 2);
    float* kmean = (float*)take((size_t)8 * 64 * 64 * 4);
    float2* rope = (float2*)take((size_t)SEQ * 32 * 8);

    k_rope_table<<<SEQ * 32 / 256, 256, 0, stream>>>(rope);
    k_copy<<<2048, 256, 0, stream>>>(x, xres, (size_t)SEQ * DM);
    for (int l = 0; l < DEPTH; ++l) {
        k_rms<<<SEQ / 4, 256, 0, stream>>>(xres, norm_w + (size_t)l * DM, hbuf);
        k_gemm_simple<0><<<dim3((NIN + 63) / 64, SEQ / 64), 256, 0, stream>>>(hbuf, w_in + (size_t)l * DM * NIN, SEQ, NIN, DM, proj, gates, nullptr);
        k_kmean<<<64, 512, 0, stream>>>(proj, kmean);
        k_moba_simple<<<dim3(SEQ / 64, 8), 64, 0, stream>>>(proj, kmean, ybuf);
        k_recur_simple<<<8, 1024, 0, stream>>>(proj, gates, rope, conv_w + (size_t)l * 4 * 512, conv_b + (size_t)l * 512, gate_bias + (size_t)l * 8,
                                               ret_nw + (size_t)l * 256, ml_nw + (size_t)l * 256, ybuf);
        k_gemm_simple<1><<<dim3(DM / 64, SEQ / 64), 256, 0, stream>>>(ybuf, w_out + (size_t)l * MIXW * DM, SEQ, DM, MIXW, nullptr, nullptr, xres);
    }
    k_final_norm<<<SEQ / 4, 256, 0, stream>>>(final_nw, xres);
}
```

```cpp
#include <hip/hip_runtime.h>
#include <stdint.h>

#define SEQ 16384
#define DM 1024
#define DEPTH 4
#define NIN 4360
#define NP 4352
#define MIXW 1024
#define C_AQ 0
#define C_AK 512
#define C_AV 1024
#define C_AG 1536
#define C_BQ 2048
#define C_BK 2304
#define C_BV 2560
#define C_BG 2816
#define C_CQ 3072
#define C_CK 3328
#define C_CV 3584
#define C_CO 3840
#define C_CG 4096

typedef unsigned short bf16_t;
__device__ __forceinline__ float bf2f(bf16_t b) { return __uint_as_float(((unsigned)b) << 16); }
__device__ __forceinline__ bf16_t f2bf(float f) { unsigned u = __float_as_uint(f); u += 0x7FFFu + ((u >> 16) & 1u); return (bf16_t)(u >> 16); }
__device__ __forceinline__ float siluf(float x) { return x / (1.f + __expf(-x)); }
__device__ __forceinline__ float sigmf(float x) { return 1.f / (1.f + __expf(-x)); }

__constant__ double c_theta[32] = {1, 0.74296395075949484, 0.55199543212815705, 0.41011270705513009, 0.30469895709035083, 0.22638034095214485, 0.16819243248808699, 0.12496091412919871, 0.092841454451947455, 0.06897785379387654, 0.051248058769609341, 0.038075460212223723, 0.028288694346259694, 0.021017480113324882, 0.015615230060004972, 0.011601553017399716, 0.0086195356647530315, 0.006404004271197283, 0.0047579443140094097, 0.0035349811050301057, 0.0026263635276533325, 0.0019512934226359642, 0.0014497406703726315, 0.0010771050560367691, 0.00080025022781610535, 0.0005945570708544394, 0.00044173447031400687, 0.0003281927872511474, 0.00024383540982688293, 0.00018116091942004152, 0.00013459603241553644, 0.0001};

__global__ void k_rope_table(float2* tab) {
    int i = blockIdx.x * blockDim.x + threadIdx.x;
    if (i >= SEQ * 32) return;
    int pos = i >> 5, f = i & 31;
    double a = (double)pos * c_theta[f];
    double k = rint(a * 0.63661977236758134308);
    double r = a - k * 1.57079632679489661923;
    r -= k * 6.123233995736766e-17;
    double r2 = r * r;
    double s = r * (1.0 + r2 * (-1.0 / 6 + r2 * (1.0 / 120 + r2 * (-1.0 / 5040 + r2 * (1.0 / 362880 + r2 * (-1.0 / 39916800 + r2 * (1.0 / 6227020800.0)))))));
    double c = 1.0 + r2 * (-0.5 + r2 * (1.0 / 24 + r2 * (-1.0 / 720 + r2 * (1.0 / 40320 + r2 * (-1.0 / 3628800 + r2 * (1.0 / 479001600.0 + r2 * (-1.0 / 87178291200.0)))))));
    long long kq = (long long)k; int q = (int)(kq & 3);
    double cs, sn;
    if (q == 0) { cs = c; sn = s; } else if (q == 1) { cs = -s; sn = c; } else if (q == 2) { cs = -c; sn = -s; } else { cs = s; sn = -c; }
    tab[i] = make_float2((float)cs, (float)sn);
}

__global__ void k_copy(const float* __restrict__ src, float* __restrict__ dst, size_t n) {
    size_t i = (size_t)blockIdx.x * blockDim.x + threadIdx.x;
    for (; i < n; i += (size_t)gridDim.x * blockDim.x) dst[i] = src[i];
}

__global__ void k_rms(const float* __restrict__ x, const float* __restrict__ w, float* __restrict__ h) {
    int row = blockIdx.x * 4 + (threadIdx.x >> 6), lane = threadIdx.x & 63;
    const float* xr = x + (size_t)row * DM;
    float v[16]; float ss = 0.f;
#pragma unroll
    for (int i = 0; i < 16; ++i) { v[i] = xr[lane + 64 * i]; ss += v[i] * v[i]; }
#pragma unroll
    for (int o = 32; o > 0; o >>= 1) ss += __shfl_xor(ss, o);
    float rs = rsqrtf(ss * (1.f / DM) + 1e-6f);
#pragma unroll
    for (int i = 0; i < 16; ++i) h[(size_t)row * DM + lane + 64 * i] = v[i] * rs * w[lane + 64 * i];
}

template <int MODE>
__global__ void __launch_bounds__(256) k_gemm_simple(const void* __restrict__ Av, const float* __restrict__ B, int M, int N, int K,
                                                     bf16_t* __restrict__ proj, float* __restrict__ gates, float* __restrict__ xres) {
    __shared__ float As[16][64 + 4];
    __shared__ float Bs[16][64 + 4];
    int tx = threadIdx.x & 15, ty = threadIdx.x >> 4;
    int m0 = blockIdx.y * 64, n0 = blockIdx.x * 64;
    float acc[4][4];
#pragma unroll
    for (int i = 0; i < 4; ++i)
#pragma unroll
        for (int j = 0; j < 4; ++j) acc[i][j] = 0.f;
    for (int k0 = 0; k0 < K; k0 += 16) {
        {
            int r = threadIdx.x >> 2, c4 = (threadIdx.x & 3) * 4;
            float a0, a1, a2, a3;
            if (MODE == 0) { const float* A = (const float*)Av; const float* p = A + (size_t)(m0 + r) * K + k0 + c4; a0 = p[0]; a1 = p[1]; a2 = p[2]; a3 = p[3]; }
            else { const bf16_t* A = (const bf16_t*)Av; const int kc = k0 + c4; const int ycol = kc < 512 ? C_AG + kc : (kc < 768 ? C_BG + kc - 512 : C_CG + kc - 768); const bf16_t* p = A + (size_t)(m0 + r) * NP + ycol; a0 = bf2f(p[0]); a1 = bf2f(p[1]); a2 = bf2f(p[2]); a3 = bf2f(p[3]); }
            As[c4 + 0][r] = a0; As[c4 + 1][r] = a1; As[c4 + 2][r] = a2; As[c4 + 3][r] = a3;
        }
        {
            int r = threadIdx.x >> 4, c4 = (threadIdx.x & 15) * 4;
#pragma unroll
            for (int j = 0; j < 4; ++j) { int n = n0 + c4 + j; Bs[r][c4 + j] = (n < N) ? B[(size_t)(k0 + r) * N + n] : 0.f; }
        }
        __syncthreads();
#pragma unroll
        for (int kk = 0; kk < 16; ++kk) {
            float a[4], b[4];
#pragma unroll
            for (int i = 0; i < 4; ++i) a[i] = As[kk][ty * 4 + i];
#pragma unroll
            for (int j = 0; j < 4; ++j) b[j] = Bs[kk][tx * 4 + j];
#pragma unroll
            for (int i = 0; i < 4; ++i)
#pragma unroll
                for (int j = 0; j < 4; ++j) acc[i][j] = fmaf(a[i], b[j], acc[i][j]);
        }
        __syncthreads();
    }
#pragma unroll
    for (int i = 0; i < 4; ++i)
#pragma unroll
        for (int j = 0; j < 4; ++j) {
            int m = m0 + ty * 4 + i, n = n0 + tx * 4 + j;
            if (n >= N) continue;
            if (MODE == 0) { if (n < NP) proj[(size_t)m * NP + n] = f2bf(acc[i][j]); else gates[(size_t)m * 8 + (n - NP)] = acc[i][j]; }
            else xres[(size_t)m * N + n] += acc[i][j];
        }
}

__global__ void k_kmean(const bf16_t* __restrict__ proj, float* __restrict__ kmean) {
    int n = blockIdx.x, c = threadIdx.x;
    float s = 0.f;
    for (int r = 0; r < 256; ++r) s += bf2f(proj[(size_t)(n * 256 + r) * NP + C_AK + c]);
    int h = c >> 6, d = c & 63;
    kmean[((size_t)h * 64 + n) * 64 + d] = s * (1.f / 256.f);
}

__global__ void __launch_bounds__(64) k_moba_simple(bf16_t* proj, const float* __restrict__ kmean) {
    int h = blockIdx.y, t = blockIdx.x * 64 + threadIdx.x;
    float q[64];
    const bf16_t* qp = proj + (size_t)t * NP + C_AQ + h * 64;
#pragma unroll
    for (int d = 0; d < 64; ++d) q[d] = bf2f(qp[d]);
    int j = t >> 8;
    float g0 = -INFINITY, g1 = -INFINITY, g2 = -INFINITY; int i0 = 0, i1 = 1, i2 = 2;
    for (int n = 0; n < j; ++n) {
        const float* km = kmean + ((size_t)h * 64 + n) * 64;
        float g = 0.f;
#pragma unroll
        for (int d = 0; d < 64; ++d) g = fmaf(q[d], km[d], g);
        if (g > g0) { g2 = g1; i2 = i1; g1 = g0; i1 = i0; g0 = g; i0 = n; }
        else if (g > g1) { g2 = g1; i2 = i1; g1 = g; i1 = n; }
        else if (g > g2) { g2 = g; i2 = n; }
    }
    int nsel = j < 3 ? j : 3;
    float slope = exp2f(-(float)(h + 1));
    float m = -INFINITY, l = 0.f; float o[64];
#pragma unroll
    for (int d = 0; d < 64; ++d) o[d] = 0.f;
    for (int seg = 0; seg <= nsel; ++seg) {
        int blk, nk;
        if (seg < nsel) { blk = seg == 0 ? i0 : (seg == 1 ? i1 : i2); nk = 256; }
        else { blk = j; nk = t - j * 256 + 1; }
        for (int kk = 0; kk < nk; ++kk) {
            int kp = blk * 256 + kk;
            const bf16_t* krow = proj + (size_t)kp * NP + C_AK + h * 64;
            const bf16_t* vrow = proj + (size_t)kp * NP + C_AV + h * 64;
            float s = 0.f;
#pragma unroll
            for (int d = 0; d < 64; ++d) s = fmaf(q[d], bf2f(krow[d]), s);
            s = s * 0.125f - slope * (float)(t - kp);
            float mn = fmaxf(m, s);
            float sc = __expf(m - mn), p = __expf(s - mn);
            l = l * sc + p;
#pragma unroll
            for (int d = 0; d < 64; ++d) o[d] = fmaf(o[d], sc, p * bf2f(vrow[d]));
            m = mn;
        }
    }
    float inv = 1.f / l;
    const bf16_t* gp = proj + (size_t)t * NP + C_AG + h * 64;
#pragma unroll
    for (int d = 0; d < 64; ++d) { float gv = bf2f(gp[d]); proj[(size_t)t * NP + C_AG + h * 64 + d] = f2bf(o[d] * inv * siluf(gv)); }
}

__global__ void __launch_bounds__(1024) k_recur_simple(bf16_t* proj, const float* __restrict__ gates, const float2* __restrict__ rope,
                                                       const float* __restrict__ conv_w, const float* __restrict__ conv_b, const float* __restrict__ gate_bias,
                                                       const float* __restrict__ ret_nw, const float* __restrict__ ml_nw) {
    __shared__ float red[2][17][64];
    __shared__ float sh_den[2][16];
    const int tid = threadIdx.x, e = tid & 63, dq = tid >> 6;
    const bool is_ret = blockIdx.x < 4;
    const int h = blockIdx.x & 3;
    float S[4] = {0.f, 0.f, 0.f, 0.f};
    float nst[4] = {0.f, 0.f, 0.f, 0.f};
    float mst = 0.f;
    const float gamma = 1.f - exp2f(-5.f - (float)h);
    float cw_q[4][4], cw_k[4][4], cb_q[4], cb_k[4];
    if (!is_ret) {
#pragma unroll
        for (int i = 0; i < 4; ++i) {
            int c = h * 64 + dq * 4 + i;
#pragma unroll
            for (int j = 0; j < 4; ++j) { cw_q[j][i] = conv_w[j * 512 + c]; cw_k[j][i] = conv_w[j * 512 + 256 + c]; }
            cb_q[i] = conv_b[c]; cb_k[i] = conv_b[256 + c];
        }
    }
    const float ib = is_ret ? 0.f : gate_bias[h], fb = is_ret ? 0.f : gate_bias[4 + h];
    for (int t = 0; t < SEQ; ++t) {
        const bf16_t* pr = proj + (size_t)t * NP;
        float qv[4], kv[4], ve;
        float wi = 1.f, wf = gamma;
        if (is_ret) {
#pragma unroll
            for (int i = 0; i < 4; ++i) {
                int d = dq * 4 + i; int f = d & 31;
                float2 cs = rope[t * 32 + f];
                float q1 = bf2f(pr[C_BQ + h * 64 + f]), q2 = bf2f(pr[C_BQ + h * 64 + 32 + f]);
                float k1 = bf2f(pr[C_BK + h * 64 + f]), k2 = bf2f(pr[C_BK + h * 64 + 32 + f]);
                if (d < 32) { qv[i] = q1 * cs.x - q2 * cs.y; kv[i] = k1 * cs.x - k2 * cs.y; }
                else { qv[i] = q1 * cs.y + q2 * cs.x; kv[i] = k1 * cs.y + k2 * cs.x; }
                kv[i] *= 0.125f;
            }
            ve = bf2f(pr[C_BV + h * 64 + e]);
        } else {
#pragma unroll
            for (int i = 0; i < 4; ++i) {
                int c = h * 64 + dq * 4 + i;
                float aq = cb_q[i], ak = cb_k[i];
#pragma unroll
                for (int j = 0; j < 4; ++j) {
                    int tt = t - 3 + j;
                    if (tt >= 0) { aq = fmaf(cw_q[j][i], bf2f(proj[(size_t)tt * NP + C_CQ + c]), aq); ak = fmaf(cw_k[j][i], bf2f(proj[(size_t)tt * NP + C_CK + c]), ak); }
                }
                qv[i] = siluf(aq); kv[i] = siluf(ak) * 0.125f;
            }
            ve = bf2f(pr[C_CV + h * 64 + e]);
            float ipre = gates[(size_t)t * 8 + h] + ib, fpre = gates[(size_t)t * 8 + 4 + h] + fb;
            float logf = fminf(fpre, 0.f) - log1pf(__expf(-fabsf(fpre)));
            float mnew = fmaxf(logf + mst, ipre);
            wf = __expf(logf + mst - mnew); wi = __expf(ipre - mnew); mst = mnew;
        }
        float part = 0.f, pden = 0.f;
#pragma unroll
        for (int i = 0; i < 4; ++i) {
            S[i] = wf * S[i] + wi * kv[i] * ve;
            part = fmaf(qv[i], S[i], part);
            if (!is_ret) { nst[i] = wf * nst[i] + wi * kv[i]; pden = fmaf(qv[i], nst[i], pden); }
        }
        const int pb = t & 1;
        red[pb][dq][e] = part;
        if (!is_ret && e == 0) sh_den[pb][dq] = pden;
        __syncthreads();
        if (tid < 64) {
            float o = 0.f;
#pragma unroll
            for (int g = 0; g < 16; ++g) o += red[pb][g][e];
            const bf16_t* gp;
            float nw;
            if (is_ret) { gp = pr + C_BG + h * 64 + e; nw = ret_nw[h * 64 + e]; }
            else {
                float den = 0.f;
#pragma unroll
                for (int g = 0; g < 16; ++g) den += sh_den[pb][g];
                o = o / fmaxf(fabsf(den), __expf(-mst));
                o *= sigmf(bf2f(pr[C_CO + h * 64 + e]));
                gp = pr + C_CG + h * 64 + e; nw = ml_nw[h * 64 + e];
            }
            float mu = o;
#pragma unroll
            for (int of = 32; of > 0; of >>= 1) mu += __shfl_xor(mu, of);
            mu *= (1.f / 64.f);
            float dv = o - mu, var = dv * dv;
#pragma unroll
            for (int of = 32; of > 0; of >>= 1) var += __shfl_xor(var, of);
            var *= (1.f / 64.f);
            float r = dv * rsqrtf(var + 1e-5f) * nw * siluf(bf2f(*gp));
            proj[(size_t)t * NP + (is_ret ? C_BG : C_CG) + h * 64 + e] = f2bf(r);
        }
    }
}

__global__ void k_final_norm(const float* __restrict__ w, float* __restrict__ xio) {
    int row = blockIdx.x * 4 + (threadIdx.x >> 6), lane = threadIdx.x & 63;
    float* xr = xio + (size_t)row * DM;
    float v[16]; float ss = 0.f;
#pragma unroll
    for (int i = 0; i < 16; ++i) { v[i] = xr[lane + 64 * i]; ss += v[i] * v[i]; }
#pragma unroll
    for (int o = 32; o > 0; o >>= 1) ss += __shfl_xor(ss, o);
    float rs = rsqrtf(ss * (1.f / DM) + 1e-6f);
#pragma unroll
    for (int i = 0; i < 16; ++i) xr[lane + 64 * i] = v[i] * rs * w[lane + 64 * i];
}


#define WS_CTL      0ull
#define CTL_BYTES   65536ull
#define WS_WTIN     (WS_CTL + CTL_BYTES)
#define WS_WG       (WS_WTIN + 4352ull * 1024 * 2)
#define WS_WTOUT    (WS_WG + 8ull * 1024 * 4)
#define WS_ROPE     (WS_WTOUT + 1024ull * 1024 * 2)
#define WS_SSQP     (WS_ROPE + (size_t)SEQ * 32 * 8)
#define WS_PROJ     (WS_SSQP + (size_t)SEQ * 16)
#define WS_GATES    (WS_PROJ + (size_t)SEQ * NP * 2)
#define WS_KMP      (WS_GATES + (size_t)SEQ * 32)
#define WS_KMEAN    (WS_KMP + 64ull * 2 * 512 * 4)
#define WS_R1       (WS_KMEAN + 8ull * 64 * 64 * 4)
#define WS_XB       WS_R1
#define WS_END0     (WS_R1 + (size_t)SEQ * DM * 2)

#define CW_BAR 0

typedef short bf16x8 __attribute__((ext_vector_type(8)));
typedef float f32x4 __attribute__((ext_vector_type(4)));
typedef unsigned u32x4 __attribute__((ext_vector_type(4)));
#define GAS __attribute__((address_space(1)))
#define LAS __attribute__((address_space(3)))
#define LDS_WAIT() asm volatile("s_waitcnt lgkmcnt(0)" ::: "memory")
#define VM_WAIT() asm volatile("s_waitcnt vmcnt(0)" ::: "memory")
__device__ __forceinline__ unsigned pk2(float lo, float hi) { return (unsigned)f2bf(lo) | ((unsigned)f2bf(hi) << 16); }

#define XB_TMO      128
#define XB_XCNT(j)  (256  + 64 * (j))
#define XB_XSUB(j)  (1280 + 64 * (j))
#define XB_XGEN(j)  (2304 + 64 * (j))
#define XB_TOP      3328
#define XB_TOPGEN   3392
#define XCD_BAR_WORDS 3456
#define XB_SPIN_CAP (1u << 18)
__device__ __forceinline__ unsigned xb_ld(unsigned* p)              { return __hip_atomic_load(p, __ATOMIC_RELAXED, __HIP_MEMORY_SCOPE_AGENT); }
__device__ __forceinline__ unsigned xb_add(unsigned* p, unsigned v) { return __hip_atomic_fetch_add(p, v, __ATOMIC_RELAXED, __HIP_MEMORY_SCOPE_AGENT); }
__device__ __forceinline__ unsigned xb_xcc_id() { return (unsigned)__builtin_amdgcn_s_getreg((3 << 11) | 20) & 0xFu; }
#define XB_SPIN(cond, bar) do { unsigned _sp = 0; while (cond) { __builtin_amdgcn_s_sleep(1); \
    if ((++_sp & 255u) == 0u) { if (xb_ld(&(bar)[XB_TMO])) break; if (_sp > XB_SPIN_CAP) { atomicAdd(&(bar)[XB_TMO], 1u); break; } } } } while (0)
struct XcdBarrier { unsigned* bar; unsigned x; volatile LAS unsigned* st; };
__device__ __forceinline__ XcdBarrier xcd_barrier_post(unsigned* bar, volatile LAS unsigned* st) {
    XcdBarrier b; b.bar = bar; b.x = xb_xcc_id(); b.st = st;
    if (threadIdx.x == 0) (void)xb_add(&bar[XB_XCNT(b.x)], 1u);
    return b;
}
__device__ __forceinline__ void xcd_barrier_complete(unsigned* bar, unsigned x, unsigned& nloc, unsigned& nx) {
    const unsigned G = gridDim.x * gridDim.y * gridDim.z;
    unsigned sum, cnt, mine, sp = 0u;
    for (;;) {
        sum = 0u; cnt = 0u; mine = 0u;
#pragma unroll
        for (unsigned j = 0; j < 16; ++j) { const unsigned c = xb_ld(&bar[XB_XCNT(j)]); sum += c; cnt += (c > 0u) ? 1u : 0u; mine = (j == x) ? c : mine; }
        if (sum == G) break;
        __builtin_amdgcn_s_sleep(1);
        if ((++sp & 255u) == 0u) { if (xb_ld(&bar[XB_TMO])) break; if (sp > XB_SPIN_CAP) { atomicAdd(&bar[XB_TMO], 1u); break; } }
    }
    nloc = mine > 0u ? mine : 1u; nx = cnt > 0u ? cnt : 1u;
}
__device__ __forceinline__ void xcd_barrier(const XcdBarrier& b) {
    asm volatile("s_waitcnt vmcnt(0)" ::: "memory");
    __syncthreads();
    if (threadIdx.x == 0) {
        unsigned* bar = b.bar;
        __builtin_amdgcn_s_waitcnt(0);
        unsigned nloc = b.st[0], nx = b.st[1];
        if (nloc == 0u) { xcd_barrier_complete(bar, b.x, nloc, nx); b.st[0] = nloc; b.st[1] = nx; }
        const unsigned old = xb_add(&bar[XB_XSUB(b.x)], 1u);
        const unsigned gen = old / nloc;
        if (old + 1u == (gen + 1u) * nloc) {
            __builtin_amdgcn_fence(__ATOMIC_RELEASE, "agent");
            asm volatile("s_waitcnt vmcnt(0)" ::: "memory");
            const unsigned og = xb_add(&bar[XB_TOP], 1u);
            const unsigned tg = og / nx;
            if (og + 1u == (tg + 1u) * nx) xb_add(&bar[XB_TOPGEN], 1u);
            else XB_SPIN(xb_ld(&bar[XB_TOPGEN]) == tg, bar);
            __builtin_amdgcn_fence(__ATOMIC_ACQUIRE, "agent");
            xb_add(&bar[XB_XGEN(b.x)], 1u);
            asm volatile("s_waitcnt vmcnt(0)" ::: "memory");
        } else {
            XB_SPIN(xb_ld(&bar[XB_XGEN(b.x)]) == gen, bar);
            __builtin_amdgcn_fence(__ATOMIC_ACQUIRE, "agent");
            asm volatile("s_waitcnt vmcnt(0)" ::: "memory");
        }
    }
    __syncthreads();
}

namespace pg8 {
#define PG8_LAS __attribute__((address_space(3)))
constexpr int BM = 256, BK = 64, HALF = 128, HTB = HALF * BK * 2  , STAGE_BYTES = 8 * HTB, NXCD = 8, WGM = 8;
__host__ __device__ __forceinline__ int lds_byte(int r, int c) { const int st = (r >> 4) * 2 + (c >> 5), rr = r & 15, cc = c & 31, ob = rr * 64 + cc * 2; return st * 1024 + (ob ^ (((ob >> 9) & 1) << 5)); }
__host__ __device__ __forceinline__ void stage_rc(int b, int& R, int& C) { const int st = b / 1024, sb = b % 1024, swz = sb ^ (((sb >> 9) & 1) << 5); R = (st >> 1) * 16 + swz / 64; C = (st & 1) * 32 + (swz % 64) / 2; }
__host__ __device__ __forceinline__ int perm32(int rho) { const int n = rho >> 4, i = rho & 15; return 8 * (i >> 2) + 4 * n + (i & 3); }
struct Unit { int pm, pn; };
struct Gemm { const bf16_t* A; const bf16_t* Bt; int M, N, K, lda; };
template <bool YG> __device__ __forceinline__ size_t koffA(int t) {
    if (!YG) return (size_t)t * (BK * 2);
    const int col = t < 8 ? C_AG + 64 * t : (t < 12 ? C_BG + 64 * (t - 8) : C_CG + 64 * (t - 12));
    return (size_t)col * 2;
}
struct StaticOrder {
    int nM, nN, nwg, G, c;
    __host__ __device__ void init(int M, int N, int G_, int c_) { nM = M / BM; nN = N / BM; nwg = nM * nN; G = G_; c = c_; }
    __host__ __device__ bool next(int i, Unit& u) const {
        const long L = (long)i * G + c; if (L >= nwg) return false;
        int wgid = (int)L; { const int q = nwg / NXCD, r = nwg % NXCD, xcd = wgid % NXCD, off = wgid / NXCD; wgid = (xcd < r ? xcd * (q + 1) : r * (q + 1) + (xcd - r) * q) + off; }
        const int nig = WGM * nN, gid = wgid / nig, fm = gid * WGM, gsz = (nM - fm) < WGM ? (nM - fm) : WGM;
        u.pm = fm + ((wgid % nig) % gsz); u.pn = (wgid % nig) / gsz; return true;
    }
    __device__ __forceinline__ void a_ready(const Unit&) const {}
    __device__ __forceinline__ void done(const Unit&) const {}
};
__device__ __forceinline__ unsigned cvt_pk_bf16(float lo, float hi) { unsigned r; asm volatile("v_cvt_pk_bf16_f32 %0, %1, %2" : "=v"(r) : "v"(lo), "v"(hi)); return r; }

struct EpiProj {
    static constexpr bool PERM = true, AFTER_DRAIN = false;
    bf16_t* proj; const float* ssqp; float* kmp;
    __device__ __forceinline__ void operator()(const f32x4 (&acc)[2][2][4][2], const Unit& u, int wr, int wc, int fr, int fq) const {
        int row0 = u.pm * BM + wr * 64 + fr, col0 = u.pn * BM + wc * 32 + 8 * fq;
        asm volatile("" : "+v"(row0), "+v"(col0));
        const bool do_km = (u.pn == 2 || u.pn == 3);
        f32x4 cs[2][2];
#pragma unroll
        for (int bj = 0; bj < 2; ++bj)
#pragma unroll
            for (int n = 0; n < 2; ++n) cs[bj][n] = (f32x4){0.f, 0.f, 0.f, 0.f};
#pragma unroll
        for (int ai = 0; ai < 2; ++ai)
#pragma unroll
            for (int m = 0; m < 4; ++m) {
                const int r = row0 + ai * HALF + m * 16;
                const f32x4 s4 = *(const f32x4*)(ssqp + (size_t)r * 4);
                const float rs = rsqrtf(((s4[0] + s4[1]) + (s4[2] + s4[3])) * (1.0f / 1024.0f) + 1e-6f);
                bf16_t* rowp = proj + (size_t)r * NP + col0;
#pragma unroll
                for (int bj = 0; bj < 2; ++bj) {
                    const f32x4 v0 = acc[ai][bj][m][0] * rs, v1 = acc[ai][bj][m][1] * rs;
                    u32x4 w; w.x = cvt_pk_bf16(v0[0], v0[1]); w.y = cvt_pk_bf16(v0[2], v0[3]); w.z = cvt_pk_bf16(v1[0], v1[1]); w.w = cvt_pk_bf16(v1[2], v1[3]);
                    *(u32x4*)(rowp + bj * HALF) = w;
                    cs[bj][0] += v0; cs[bj][1] += v1;
                }
            }
        if (do_km) {
#pragma unroll
            for (int bj = 0; bj < 2; ++bj)
#pragma unroll
                for (int n = 0; n < 2; ++n)
#pragma unroll
                    for (int i = 0; i < 4; ++i) {
                        float v = cs[bj][n][i];
                        v += __shfl_xor(v, 1); v += __shfl_xor(v, 2); v += __shfl_xor(v, 4); v += __shfl_xor(v, 8);
                        cs[bj][n][i] = v;
                    }
            if (fr == 0) {
                float* kp = kmp + (size_t)(u.pm * 2 + wr) * 512 + (col0 - C_AK);
#pragma unroll
                for (int bj = 0; bj < 2; ++bj) { *(f32x4*)(kp + bj * HALF) = cs[bj][0]; *(f32x4*)(kp + bj * HALF + 4) = cs[bj][1]; }
            }
        }
    }
};

struct EpiOut {
    static constexpr bool PERM = false, AFTER_DRAIN = true;
    float* xres; bf16_t* xb; float* ssqp;
    __device__ __forceinline__ void fused(f32x4 (&acc)[2][2][4][2], const Unit& u, int wr, int wc, int fr, int fq, PG8_LAS unsigned char* lds, int wid, int lane) const {
        PG8_LAS float* P = (PG8_LAS float*)lds;
        int row0 = wr * 64 + fr, col0 = u.pn * BM + wc * 32 + 4 * fq;
        asm volatile("" : "+v"(row0), "+v"(col0));
#pragma unroll
        for (int ai = 0; ai < 2; ++ai)
#pragma unroll
            for (int m = 0; m < 4; ++m) {
                const int rl = row0 + ai * HALF + m * 16; const size_t off = (size_t)(u.pm * BM + rl) * DM + col0;
                float ss = 0.f;
#pragma unroll
                for (int bj = 0; bj < 2; ++bj)
#pragma unroll
                    for (int n = 0; n < 2; ++n) {
                        const size_t o2 = off + bj * HALF + n * 16;
                        const f32x4 xn = *(const f32x4*)(xres + o2) + acc[ai][bj][m][n];
                        *(f32x4*)(xres + o2) = xn;
                        uint2 w; w.x = cvt_pk_bf16(xn[0], xn[1]); w.y = cvt_pk_bf16(xn[2], xn[3]);
                        *(uint2*)(xb + o2) = w;
                        ss += (xn[0] * xn[0] + xn[1] * xn[1]) + (xn[2] * xn[2] + xn[3] * xn[3]);
                    }
                ss += __shfl_xor(ss, 16); ss += __shfl_xor(ss, 32);
                if (fq == 0) P[rl * 4 + wc] = ss;
            }
        asm volatile("s_waitcnt lgkmcnt(0)" ::: "memory"); __builtin_amdgcn_s_barrier(); asm volatile("" ::: "memory");
        const int t = wid * 64 + lane;
        if (t < 256) { const f32x4 p = *(const PG8_LAS f32x4*)(P + t * 4); ssqp[(size_t)(u.pm * BM + t) * 4 + u.pn] = (p[0] + p[1]) + (p[2] + p[3]); }
        asm volatile("s_waitcnt lgkmcnt(0)" ::: "memory"); __builtin_amdgcn_s_barrier(); asm volatile("" ::: "memory");
    }
};
template <class Epi, class Sched, bool YG>
__device__ __forceinline__ void gemm_phase(PG8_LAS unsigned char* lds, const Gemm g, const Sched& S, const Epi& E) {
    int tid_ = threadIdx.x; asm volatile("" : "+v"(tid_));
    const int tid = tid_, wid = __builtin_amdgcn_readfirstlane(tid >> 6), lane = tid & 63, wr = wid >> 2, wc = wid & 3, fr = lane & 15, fq = lane >> 4;
    const int K = g.K, nt = K / BK;
    unsigned voffA[2], voffB[2];
#pragma unroll
    for (int i = 0; i < 2; ++i) { int R, C; stage_rc(tid * 16 + i * 8192, R, C); const int Rb = Epi::PERM ? ((R & ~31) + perm32(R & 31)) : R;
        voffA[i] = (unsigned)(R * g.lda + C) * 2u; voffB[i] = (unsigned)(Rb * K + C) * 2u; }
    const size_t kstep = (size_t)(BK * 2);
    const size_t hstep = (size_t)HALF * K * 2;
    const size_t tstep = 2 * hstep;
    const size_t hstepA = (size_t)HALF * g.lda * 2, tstepA = 2 * hstepA;
    const unsigned ldsw = (unsigned)wid * 1024u;
    const int aoff = lds_byte(wr * 64 + fr, fq * 8), boff = lds_byte(wc * 32 + fr, fq * 8);
#define PG8_SA(b, h) (((b) * 2 + (h)) * HTB)
#define PG8_SB(b, h) ((4 + (b) * 2 + (h)) * HTB)
#define PG8_STAGE(bufoff, gbase, voff) do { _Pragma("unroll") for (int _i = 0; _i < 2; ++_i) \
        __builtin_amdgcn_global_load_lds((const unsigned*)((const char*)(gbase) + (voff)[_i]), (PG8_LAS unsigned*)(lds + (bufoff) + ldsw + _i * 8192), 16, 0, 0); } while (0)
#define PG8_LDA(dst, b, h) do { _Pragma("unroll") for (int m = 0; m < 4; ++m) _Pragma("unroll") for (int k = 0; k < 2; ++k) dst[m][k] = *(const PG8_LAS bf16x8*)(lds + PG8_SA(b, h) + aoff + m * 2048 + k * 1024); } while (0)
#define PG8_LDB(dst, b, h) do { _Pragma("unroll") for (int n = 0; n < 2; ++n) _Pragma("unroll") for (int k = 0; k < 2; ++k) dst[n][k] = *(const PG8_LAS bf16x8*)(lds + PG8_SB(b, h) + boff + n * 2048 + k * 1024); } while (0)
#define PG8_MMA(ai, bj, At, Bt) do { __builtin_amdgcn_s_setprio(1); _Pragma("unroll") for (int m = 0; m < 4; ++m) _Pragma("unroll") for (int n = 0; n < 2; ++n) _Pragma("unroll") for (int k = 0; k < 2; ++k) \
        acc[ai][bj][m][n] = __builtin_amdgcn_mfma_f32_16x16x32_bf16(Bt[n][k], At[m][k], acc[ai][bj][m][n], 0, 0, 0); __builtin_amdgcn_s_setprio(0); } while (0)
#define PG8_WAIT_V(n) asm volatile("s_waitcnt vmcnt(" #n ")" ::: "memory")
#define PG8_WAIT_L(n) asm volatile("s_waitcnt lgkmcnt(" #n ")" ::: "memory")
#define PG8_BAR __builtin_amdgcn_s_barrier()
#define PG8_SCHED __builtin_amdgcn_sched_barrier(0)
    Unit cur, nxt; int ui = 0;
    if (!S.next(0, cur)) return;
    f32x4 acc[2][2][4][2];
#pragma unroll
    for (int a = 0; a < 2; ++a)
#pragma unroll
        for (int b = 0; b < 2; ++b)
#pragma unroll
            for (int m = 0; m < 4; ++m)
#pragma unroll
                for (int n = 0; n < 2; ++n) acc[a][b][m][n] = (f32x4){0.f, 0.f, 0.f, 0.f};
    bf16x8 At[4][2], B0[2][2], B1[2][2];
    const char* cA = (const char*)g.A + (size_t)cur.pm * tstepA; const char* cB = (const char*)g.Bt + (size_t)cur.pn * tstep;
    S.a_ready(cur);
    PG8_STAGE(PG8_SB(0, 0), cB, voffB); PG8_STAGE(PG8_SA(0, 0), cA + koffA<YG>(0), voffA); PG8_STAGE(PG8_SB(0, 1), cB + hstep, voffB); PG8_STAGE(PG8_SA(0, 1), cA + koffA<YG>(0) + hstepA, voffA);
    if (wr == 1) PG8_BAR;
    PG8_WAIT_V(4); PG8_BAR;
    PG8_STAGE(PG8_SB(1, 0), cB + kstep, voffB); PG8_STAGE(PG8_SA(1, 0), cA + koffA<YG>(1), voffA); PG8_STAGE(PG8_SB(1, 1), cB + hstep + kstep, voffB);
    PG8_WAIT_V(6); PG8_BAR;
    for (;;) {
        const bool has_next = S.next(ui + 1, nxt);
        const char* nA = has_next ? (const char*)g.A + (size_t)nxt.pm * tstepA : cA; const char* nB = has_next ? (const char*)g.Bt + (size_t)nxt.pn * tstep : cB;
        for (int t = 0; t < nt; t += 2) {
            const bool last = (t == nt - 2);
            const char* a1 = cA + koffA<YG>(t + 1);
            const char* a2 = last ? nA + koffA<YG>(0) : cA + koffA<YG>(t + 2); const char* b2 = last ? nB : cB + (size_t)(t + 2) * kstep;
            const char* a3 = last ? nA + koffA<YG>(1) : cA + koffA<YG>(t + 3); const char* b3 = b2 + kstep;
            if (last && has_next) S.a_ready(nxt);
            PG8_LDB(B0, 0, 0); PG8_SCHED; PG8_LDA(At, 0, 0); PG8_STAGE(PG8_SA(1, 1), a1 + hstepA, voffA);
            PG8_WAIT_L(8); PG8_BAR; PG8_WAIT_L(0); PG8_MMA(0, 0, At, B0); PG8_BAR; PG8_SCHED;
            PG8_LDB(B1, 0, 1); PG8_STAGE(PG8_SB(0, 0), b2, voffB);
            PG8_BAR; PG8_WAIT_L(0); PG8_MMA(0, 1, At, B1); PG8_BAR;
            PG8_LDA(At, 0, 1); PG8_STAGE(PG8_SA(0, 0), a2, voffA);
            PG8_BAR; PG8_WAIT_L(0); PG8_MMA(1, 0, At, B0); PG8_BAR; PG8_SCHED;
            PG8_STAGE(PG8_SB(0, 1), b2 + hstep, voffB);
            PG8_WAIT_V(6); PG8_BAR; PG8_MMA(1, 1, At, B1); PG8_BAR;
            PG8_LDB(B0, 1, 0); PG8_SCHED; PG8_LDA(At, 1, 0); PG8_STAGE(PG8_SA(0, 1), a2 + hstepA, voffA);
            PG8_WAIT_L(8); PG8_BAR; PG8_WAIT_L(0); PG8_MMA(0, 0, At, B0); PG8_BAR; PG8_SCHED;
            PG8_LDB(B1, 1, 1); PG8_STAGE(PG8_SB(1, 0), b3, voffB);
            PG8_BAR; PG8_WAIT_L(0); PG8_MMA(0, 1, At, B1); PG8_BAR;
            PG8_LDA(At, 1, 1); PG8_STAGE(PG8_SA(1, 0), a3, voffA);
            PG8_BAR; PG8_WAIT_L(0); PG8_MMA(1, 0, At, B0); PG8_BAR; PG8_SCHED;
            PG8_STAGE(PG8_SB(1, 1), b3 + hstep, voffB);
            PG8_WAIT_V(6); PG8_BAR; PG8_MMA(1, 1, At, B1); PG8_BAR;
        }
        if constexpr (!Epi::AFTER_DRAIN) { E(acc, cur, wr, wc, fr, fq); S.done(cur); }
        if (!has_next) break;
#pragma unroll
        for (int a = 0; a < 2; ++a)
#pragma unroll
            for (int b = 0; b < 2; ++b)
#pragma unroll
                for (int m = 0; m < 4; ++m)
#pragma unroll
                    for (int n = 0; n < 2; ++n) acc[a][b][m][n] = (f32x4){0.f, 0.f, 0.f, 0.f};
        cur = nxt; cA = nA; cB = nB; ++ui;
    }
    PG8_WAIT_V(0);
    if (wr == 0) PG8_BAR;
    PG8_BAR;
    if constexpr (Epi::AFTER_DRAIN) { E.fused(acc, cur, wr, wc, fr, fq, lds, wid, lane); S.done(cur); }
#undef PG8_SA
#undef PG8_SB
#undef PG8_STAGE
#undef PG8_LDA
#undef PG8_LDB
#undef PG8_MMA
#undef PG8_WAIT_V
#undef PG8_WAIT_L
#undef PG8_BAR
#undef PG8_SCHED
}

}

#define NTHREADS 512
#define LDS_BYTES 147456
#define LDS_CTL_OFF 131072

struct Args {
    const float *x, *norm_w, *w_in, *conv_w, *conv_b, *gate_bias, *ret_nw, *ml_nw, *w_out, *final_nw;
    float* out; unsigned char* ws; int ph_lo, ph_hi;
};

struct Ctx {
    LAS unsigned char* lds;
    int tid, lane, wave, G, bid;
};

__device__ __forceinline__ void transpose_item(const float* W, int K, int Nsrc, int nblk, bf16_t* WT, const float* sc, LAS float* scr, int item, int lane) {
    const int kb = item / nblk, nb = item % nblk, k0 = 64 * kb, n0 = 32 * nb;
#pragma unroll 8
    for (int i = 0; i < 32; ++i) { const int kk = 2 * i + (lane >> 5); float v = W[(size_t)(k0 + kk) * Nsrc + n0 + (lane & 31)]; if (sc) v *= sc[k0 + kk]; scr[kk * 33 + (lane & 31)] = v; }
    LDS_WAIT(); asm volatile("" ::: "memory");
    const int c = lane & 7;
#pragma unroll
    for (int j = 0; j < 4; ++j) { const int n = (lane >> 3) + 8 * j; const LAS float* s = scr + (8 * c) * 33 + n;
        u32x4 o; o.x = pk2(s[0 * 33], s[1 * 33]); o.y = pk2(s[2 * 33], s[3 * 33]); o.z = pk2(s[4 * 33], s[5 * 33]); o.w = pk2(s[6 * 33], s[7 * 33]);
        *(u32x4*)(WT + (size_t)(n0 + n) * K + k0 + 8 * c) = o; }
    LDS_WAIT(); asm volatile("" ::: "memory");
}

__device__ __forceinline__ void convert_w_in(const Ctx& c, const Args& a, int l) {
    LAS float* scr = (LAS float*)(c.lds + c.wave * 16384);
    const int gw = c.bid * 8 + c.wave, NGW = c.G * 8;
    const float* W = a.w_in + (size_t)l * DM * NIN; const float* nw = a.norm_w + (size_t)l * DM;
    bf16_t* WT = (bf16_t*)(a.ws + WS_WTIN);
    constexpr int NBLK = NP / 32, NITEMS = (DM / 64) * NBLK;
    for (int it = gw; it < NITEMS; it += NGW) transpose_item(W, DM, NIN, NBLK, WT, nw, scr, it, c.lane);
    float* WG = (float*)(a.ws + WS_WG);
    for (int i = c.bid * NTHREADS + c.tid; i < 8 * DM; i += c.G * NTHREADS) { const int j = i >> 10, k = i & 1023; WG[i] = W[(size_t)k * NIN + NP + j] * nw[k]; }
}
__device__ __forceinline__ void convert_w_out(const Ctx& c, const Args& a, int l) {
    LAS float* scr = (LAS float*)(c.lds + c.wave * 16384);
    const int gw = c.bid * 8 + c.wave, NGW = c.G * 8;
    const float* W = a.w_out + (size_t)l * MIXW * DM;
    bf16_t* WT = (bf16_t*)(a.ws + WS_WTOUT);
    constexpr int NBLK = DM / 32, NITEMS = (MIXW / 64) * NBLK;
    for (int it = gw; it < NITEMS; it += NGW) transpose_item(W, MIXW, DM, NBLK, WT, nullptr, scr, it, c.lane);
}

__device__ __forceinline__ void rope_entry(float2* tab, int i) {
    int pos = i >> 5, f = i & 31;
    double a = (double)pos * c_theta[f];
    double k = rint(a * 0.63661977236758134308);
    double r = a - k * 1.57079632679489661923;
    r -= k * 6.123233995736766e-17;
    double r2 = r * r;
    double s = r * (1.0 + r2 * (-1.0 / 6 + r2 * (1.0 / 120 + r2 * (-1.0 / 5040 + r2 * (1.0 / 362880 + r2 * (-1.0 / 39916800 + r2 * (1.0 / 6227020800.0)))))));
    double cc = 1.0 + r2 * (-0.5 + r2 * (1.0 / 24 + r2 * (-1.0 / 720 + r2 * (1.0 / 40320 + r2 * (-1.0 / 3628800 + r2 * (1.0 / 479001600.0 + r2 * (-1.0 / 87178291200.0)))))));
    long long kq = (long long)k; int q = (int)(kq & 3);
    double cs, sn;
    if (q == 0) { cs = cc; sn = s; } else if (q == 1) { cs = -s; sn = cc; } else if (q == 2) { cs = -cc; sn = -s; } else { cs = s; sn = -cc; }
    tab[i] = make_float2((float)cs, (float)sn);
}

__device__ __forceinline__ void xprep_row(const float* xrow, float* orow, bf16_t* brow, float* ssq4, int lane) {
    const f32x4* xr = (const f32x4*)xrow + lane;
    f32x4 v[4]; float s = 0.f;
#pragma unroll
    for (int j = 0; j < 4; ++j) { v[j] = xr[64 * j]; s += (v[j][0] * v[j][0] + v[j][1] * v[j][1]) + (v[j][2] * v[j][2] + v[j][3] * v[j][3]); }
#pragma unroll
    for (int o = 1; o < 64; o <<= 1) s += __shfl_xor(s, o);
    if (orow) {
#pragma unroll
        for (int j = 0; j < 4; ++j) ((f32x4*)orow + lane)[64 * j] = v[j];
    }
    unsigned long long* o8 = (unsigned long long*)brow + lane;
#pragma unroll
    for (int j = 0; j < 4; ++j) o8[64 * j] = (unsigned long long)pk2(v[j][0], v[j][1]) | ((unsigned long long)pk2(v[j][2], v[j][3]) << 32);
    if (lane == 0) *(f32x4*)ssq4 = (f32x4){s, 0.f, 0.f, 0.f};
}

__device__ __forceinline__ void phase_p0(const Ctx& c, const Args& a) {
    convert_w_in(c, a, 0);
    convert_w_out(c, a, 0);
    float2* rope = (float2*)(a.ws + WS_ROPE);
    for (int i = c.bid * NTHREADS + c.tid; i < SEQ * 32; i += c.G * NTHREADS) rope_entry(rope, i);
    const int gw = c.bid * 8 + c.wave, NGW = c.G * 8;
    bf16_t* xb = (bf16_t*)(a.ws + WS_XB); float* ssqp = (float*)(a.ws + WS_SSQP);
    for (int m = gw; m < SEQ; m += NGW) xprep_row(a.x + (size_t)m * DM, a.out + (size_t)m * DM, xb + (size_t)m * DM, ssqp + (size_t)m * 4, c.lane);
}

__device__ __forceinline__ void gates_rows(const Ctx& c, const Args& a) {
    const bf16_t* xb = (const bf16_t*)(a.ws + WS_XB); const float* WG = (const float*)(a.ws + WS_WG);
    const float* ssqp = (const float*)(a.ws + WS_SSQP); float* gates = (float*)(a.ws + WS_GATES);
    for (int rb = c.bid; rb < SEQ / 64; rb += c.G) {
        const int row = rb * 64 + (c.tid >> 3), j = c.tid & 7;
        const bf16_t* xr = xb + (size_t)row * DM; const float* wr = WG + (size_t)j * DM;
        float acc = 0.f;
#pragma unroll 4
        for (int k = 0; k < DM; k += 8) {
            const u32x4 xv = *(const u32x4*)(xr + k);
            const f32x4 w0 = *(const f32x4*)(wr + k), w1 = *(const f32x4*)(wr + k + 4);
            acc = fmaf(__uint_as_float(xv.x << 16), w0[0], acc); acc = fmaf(__uint_as_float(xv.x & 0xffff0000u), w0[1], acc);
            acc = fmaf(__uint_as_float(xv.y << 16), w0[2], acc); acc = fmaf(__uint_as_float(xv.y & 0xffff0000u), w0[3], acc);
            acc = fmaf(__uint_as_float(xv.z << 16), w1[0], acc); acc = fmaf(__uint_as_float(xv.z & 0xffff0000u), w1[1], acc);
            acc = fmaf(__uint_as_float(xv.w << 16), w1[2], acc); acc = fmaf(__uint_as_float(xv.w & 0xffff0000u), w1[3], acc);
        }
        const f32x4 s4 = *(const f32x4*)(ssqp + (size_t)row * 4);
        const float rs = rsqrtf(((s4[0] + s4[1]) + (s4[2] + s4[3])) * (1.0f / 1024.0f) + 1e-6f);
        gates[(size_t)row * 8 + j] = acc * rs;
    }
}

__device__ __forceinline__ void phase_pa(const Ctx& c, const Args& a) {
    gates_rows(c, a);
    pg8::Gemm g{(const bf16_t*)(a.ws + WS_XB), (const bf16_t*)(a.ws + WS_WTIN), SEQ, NP, DM, DM};
    pg8::StaticOrder S; S.init(SEQ, NP, c.G, c.bid);
    pg8::EpiProj E{(bf16_t*)(a.ws + WS_PROJ), (const float*)(a.ws + WS_SSQP), (float*)(a.ws + WS_KMP)};
    pg8::gemm_phase<pg8::EpiProj, pg8::StaticOrder, false>(c.lds, g, S, E);
}

__device__ __forceinline__ void phase_pe(const Ctx& c, const Args& a) {
    pg8::Gemm g{(const bf16_t*)(a.ws + WS_PROJ), (const bf16_t*)(a.ws + WS_WTOUT), SEQ, DM, MIXW, NP};
    pg8::StaticOrder S; S.init(SEQ, DM, c.G, c.bid);
    pg8::EpiOut E{a.out, (bf16_t*)(a.ws + WS_XB), (float*)(a.ws + WS_SSQP)};
    pg8::gemm_phase<pg8::EpiOut, pg8::StaticOrder, true>(c.lds, g, S, E);
}
__device__ __forceinline__ void phase_final(const Ctx& c, const Args& a) {
    const int gw = c.bid * 8 + c.wave, NGW = c.G * 8;
    const float* ssqp = (const float*)(a.ws + WS_SSQP);
    f32x4 w[4];
#pragma unroll
    for (int j = 0; j < 4; ++j) w[j] = ((const f32x4*)a.final_nw + c.lane)[64 * j];
    for (int m = gw; m < SEQ; m += NGW) {
        const f32x4 s4 = *(const f32x4*)(ssqp + (size_t)m * 4);
        const float rs = rsqrtf(((s4[0] + s4[1]) + (s4[2] + s4[3])) * (1.0f / 1024.0f) + 1e-6f);
        f32x4* xr = (f32x4*)(a.out + (size_t)m * DM) + c.lane;
#pragma unroll
        for (int j = 0; j < 4; ++j) xr[64 * j] = xr[64 * j] * rs * w[j];
    }
}

#define LIST_PER_HEAD 516096
#define WS_LIST   WS_R1
#define WS_KVRET  (WS_LIST + 8ull * LIST_PER_HEAD * 4)
#define WS_KVML   (WS_KVRET + 4ull * 64 * 4096 * 4)
#define WS_NLOC   (WS_KVML + 4ull * 128 * 4096 * 4)
#define WS_MLOC   (WS_NLOC + 4ull * 128 * 64 * 4)
#define WS_BC     (WS_MLOC + 4ull * 128 * 4)
#define WS_RPREV  WS_END0
#define WS_CPREV  (WS_RPREV + 4ull * 64 * 4096 * 2)
#define WS_NPREV  (WS_CPREV + 4ull * 128 * 4096 * 2)
#define WS_MPREV  (WS_NPREV + 4ull * 128 * 64 * 4)
#define WS_PART   (WS_MPREV + 4096ull)
#define WS_PML    (WS_PART + (size_t)SEQ * 8 * 3 * 64 * 2)
#define WS_END1   (WS_PML + (size_t)SEQ * 8 * 3 * 8)

typedef short s16x4 __attribute__((ext_vector_type(4)));
#define TILE_OFF(row, c16) ((row) * 128 + (((((c16) >> 1) ^ (((row) >> 1) & 3))) << 5) + (((c16) & 1) << 4))
#define MFMA16(a, b, c) __builtin_amdgcn_mfma_f32_16x16x32_bf16(a, b, c, 0, 0, 0)

__device__ __forceinline__ void load8f(const bf16_t* p, float (&v)[8]) {
    const u32x4 x = *(const u32x4*)p;
    v[0] = __uint_as_float(x.x << 16); v[1] = __uint_as_float(x.x & 0xffff0000u); v[2] = __uint_as_float(x.y << 16); v[3] = __uint_as_float(x.y & 0xffff0000u);
    v[4] = __uint_as_float(x.z << 16); v[5] = __uint_as_float(x.z & 0xffff0000u); v[6] = __uint_as_float(x.w << 16); v[7] = __uint_as_float(x.w & 0xffff0000u);
}
__device__ __forceinline__ u32x4 pack8(const float (&v)[8]) { u32x4 w; w.x = pk2(v[0], v[1]); w.y = pk2(v[2], v[3]); w.z = pk2(v[4], v[5]); w.w = pk2(v[6], v[7]); return w; }
__device__ __forceinline__ void tile_store8(LAS unsigned char* tile, int row, int c16, const float (&v)[8]) { *(LAS u32x4*)(tile + TILE_OFF(row, c16)) = pack8(v); }
__device__ __forceinline__ bf16x8 tile_rowfrag(LAS unsigned char* tile, int row, int c16) { return *(const LAS bf16x8*)(tile + TILE_OFF(row, c16)); }
typedef short v4i16_t __attribute__((ext_vector_type(4)));
__device__ __forceinline__ s16x4 lds_tr(LAS unsigned char* p) { return __builtin_bit_cast(s16x4, __builtin_amdgcn_ds_read_tr16_b64_v4i16((LAS v4i16_t*)p)); }
__device__ __forceinline__ bf16x8 tile_trfrag(LAS unsigned char* tile, int key0, int et, int lane) {
    const int i = lane & 15, g = lane >> 4, r1 = key0 + 4 * g + (i >> 2);
    LAS unsigned char* p = tile + r1 * 128 + ((et ^ ((r1 >> 1) & 3)) << 5) + (i & 3) * 8;
    const s16x4 a = lds_tr(p), b = lds_tr(p + 2048);
    return (bf16x8){a[0], a[1], a[2], a[3], b[0], b[1], b[2], b[3]};
}
__device__ __forceinline__ f32x4 st_tile(LAS unsigned char* Kt, int krow0, const bf16x8 (&qf)[2], int lane) {
    const int key = krow0 + (lane & 15), g = lane >> 4;
    f32x4 acc = (f32x4){0.f, 0.f, 0.f, 0.f};
    acc = MFMA16(tile_rowfrag(Kt, key, g), qf[0], acc);
    acc = MFMA16(tile_rowfrag(Kt, key, 4 + g), qf[1], acc);
    return acc;
}
__device__ __forceinline__ void pv_step(LAS unsigned char* Vt, int key0, const f32x4& s0, const f32x4& s1, f32x4 (&O)[4], int lane) {
    u32x4 pw; pw.x = pg8::cvt_pk_bf16(s0[0], s0[1]); pw.y = pg8::cvt_pk_bf16(s0[2], s0[3]); pw.z = pg8::cvt_pk_bf16(s1[0], s1[1]); pw.w = pg8::cvt_pk_bf16(s1[2], s1[3]);
    const bf16x8 pf = __builtin_bit_cast(bf16x8, pw);
#pragma unroll
    for (int et = 0; et < 4; ++et) O[et] = MFMA16(tile_trfrag(Vt, key0, et, lane), pf, O[et]);
}
__device__ __forceinline__ void cross_state(const bf16_t* St, const bf16x8 (&qf)[2], f32x4 (&X)[4], int lane) {
    const int i = lane & 15, g = lane >> 4;
#pragma unroll
    for (int et = 0; et < 4; ++et) {
        const bf16_t* rp = St + (size_t)(et * 16 + i) * 64 + 8 * g;
        const bf16x8 a0 = *(const bf16x8*)rp, a1 = *(const bf16x8*)(rp + 32);
        f32x4 acc = (f32x4){0.f, 0.f, 0.f, 0.f};
        acc = MFMA16(a0, qf[0], acc); acc = MFMA16(a1, qf[1], acc);
        X[et] = acc;
    }
}
__device__ __forceinline__ float grp4_sum(float v) { v += __shfl_xor(v, 16); v += __shfl_xor(v, 32); return v; }
__device__ __forceinline__ float grp4_max(float v) { v = fmaxf(v, __shfl_xor(v, 16)); v = fmaxf(v, __shfl_xor(v, 32)); return v; }

__device__ __forceinline__ void headnorm_store(f32x4 (&O)[4], const float* nw  , bf16_t* grow  , int lane) {
    const int g = lane >> 4;
    float s = 0.f;
#pragma unroll
    for (int et = 0; et < 4; ++et) s += (O[et][0] + O[et][1]) + (O[et][2] + O[et][3]);
    const float mu = grp4_sum(s) * (1.f / 64.f);
    float q = 0.f;
#pragma unroll
    for (int et = 0; et < 4; ++et)
#pragma unroll
        for (int r = 0; r < 4; ++r) { const float d = O[et][r] - mu; q += d * d; }
    const float rstd = rsqrtf(grp4_sum(q) * (1.f / 64.f) + 1e-5f);
#pragma unroll
    for (int et = 0; et < 4; ++et) {
        const int e = et * 16 + 4 * g;
        const uint2 gw = *(const uint2*)(grow + e);
        const f32x4 w4 = *(const f32x4*)(nw + e);
        const float g0 = __uint_as_float(gw.x << 16), g1 = __uint_as_float(gw.x & 0xffff0000u), g2 = __uint_as_float(gw.y << 16), g3 = __uint_as_float(gw.y & 0xffff0000u);
        uint2 o;
        o.x = pk2((O[et][0] - mu) * rstd * w4[0] * siluf(g0), (O[et][1] - mu) * rstd * w4[1] * siluf(g1));
        o.y = pk2((O[et][2] - mu) * rstd * w4[2] * siluf(g2), (O[et][3] - mu) * rstd * w4[3] * siluf(g3));
        *(uint2*)(grow + e) = o;
    }
}

#define LDS_KT 0
#define LDS_VT 32768
#define LDS_SCR 65536

template <bool ZETA>
__device__ __forceinline__ void ret_stage(const Ctx& c, const Args& a, int h, int T0, float lg2g) {
    const bf16_t* proj = (const bf16_t*)(a.ws + WS_PROJ); const float2* rope = (const float2*)(a.ws + WS_ROPE);
    LAS unsigned char* Kt = c.lds + LDS_KT; LAS unsigned char* Vt = c.lds + LDS_VT;
    for (int it = c.tid; it < 256 * 4; it += NTHREADS) {
        const int row = it >> 2, cq = it & 3, t = T0 + row;
        float lo[8], hi[8], olo[8], ohi[8];
        load8f(proj + (size_t)t * NP + C_BK + h * 64 + 8 * cq, lo); load8f(proj + (size_t)t * NP + C_BK + h * 64 + 32 + 8 * cq, hi);
        const float sc = ZETA ? 0.125f * exp2f(lg2g * (float)(255 - row)) : 0.125f;
        const f32x4* rp = (const f32x4*)(rope + (size_t)t * 32 + 8 * cq);
#pragma unroll
        for (int j2 = 0; j2 < 4; ++j2) { const f32x4 cs = rp[j2];
            olo[2 * j2] = (lo[2 * j2] * cs[0] - hi[2 * j2] * cs[1]) * sc; ohi[2 * j2] = (lo[2 * j2] * cs[1] + hi[2 * j2] * cs[0]) * sc;
            olo[2 * j2 + 1] = (lo[2 * j2 + 1] * cs[2] - hi[2 * j2 + 1] * cs[3]) * sc; ohi[2 * j2 + 1] = (lo[2 * j2 + 1] * cs[3] + hi[2 * j2 + 1] * cs[2]) * sc; }
        tile_store8(Kt, row, cq, olo); tile_store8(Kt, row, 4 + cq, ohi);
    }
    for (int it = c.tid; it < 256 * 8; it += NTHREADS) {
        const int row = it >> 3, c16 = it & 7;
        *(LAS u32x4*)(Vt + TILE_OFF(row, c16)) = *(const u32x4*)(proj + (size_t)(T0 + row) * NP + C_BV + h * 64 + 8 * c16);
    }
}
template <int NTOK>
__device__ __forceinline__ void kvt_mfma(const Ctx& c, float* out) {
    LAS unsigned char* Kt = c.lds + LDS_KT; LAS unsigned char* Vt = c.lds + LDS_VT;
    const int et = c.wave & 3, dt0 = (c.wave >> 2) * 2, i = c.lane & 15, g = c.lane >> 4;
    f32x4 acc0 = (f32x4){0.f, 0.f, 0.f, 0.f}, acc1 = acc0;
#pragma unroll
    for (int s = 0; s < NTOK / 32; ++s) {
        const bf16x8 af = tile_trfrag(Vt, 32 * s, et, c.lane);
        const bf16x8 b0 = tile_trfrag(Kt, 32 * s, dt0, c.lane), b1 = tile_trfrag(Kt, 32 * s, dt0 + 1, c.lane);
        acc0 = MFMA16(af, b0, acc0); acc1 = MFMA16(af, b1, acc1);
    }
#pragma unroll
    for (int r = 0; r < 4; ++r) { const int e = et * 16 + 4 * g + r; out[e * 64 + dt0 * 16 + i] = acc0[r]; out[e * 64 + (dt0 + 1) * 16 + i] = acc1[r]; }
}
__device__ __forceinline__ void ret_x1_unit(const Ctx& c, const Args& a, int h, int ch) {
    const float lg2g = log2f(1.f - exp2f(-5.f - (float)h));
    ret_stage<true>(c, a, h, ch * 256, lg2g);
    __syncthreads();
    kvt_mfma<256>(c, (float*)(a.ws + WS_KVRET) + ((size_t)h * 64 + ch) * 4096);
    __syncthreads();
}
__device__ __forceinline__ void ret_x3_tile(const Ctx& c, const Args& a, int l, int h, int ch, int wt, float lg2g) {
    bf16_t* proj = (bf16_t*)(a.ws + WS_PROJ); const float2* rope = (const float2*)(a.ws + WS_ROPE);
    LAS unsigned char* Kt = c.lds + LDS_KT; LAS unsigned char* Vt = c.lds + LDS_VT;
    const int i = c.lane & 15, g = c.lane >> 4, ql = wt * 16 + i, t = ch * 256 + ql;
    bf16x8 qf[2];
    {
        float lo[8], hi[8], olo[8], ohi[8];
        load8f(proj + (size_t)t * NP + C_BQ + h * 64 + 8 * g, lo); load8f(proj + (size_t)t * NP + C_BQ + h * 64 + 32 + 8 * g, hi);
        const f32x4* rp = (const f32x4*)(rope + (size_t)t * 32 + 8 * g);
#pragma unroll
        for (int j2 = 0; j2 < 4; ++j2) { const f32x4 cs = rp[j2];
            olo[2 * j2] = lo[2 * j2] * cs[0] - hi[2 * j2] * cs[1]; ohi[2 * j2] = lo[2 * j2] * cs[1] + hi[2 * j2] * cs[0];
            olo[2 * j2 + 1] = lo[2 * j2 + 1] * cs[2] - hi[2 * j2 + 1] * cs[3]; ohi[2 * j2 + 1] = lo[2 * j2 + 1] * cs[3] + hi[2 * j2 + 1] * cs[2]; }
        qf[0] = __builtin_bit_cast(bf16x8, pack8(olo)); qf[1] = __builtin_bit_cast(bf16x8, pack8(ohi));
    }
    const float F1 = exp2f(-lg2g), F2 = F1 * F1, F3 = F2 * F1, c16 = exp2f(-16.f * lg2g);
    float Ekt = exp2f(lg2g * (float)(ql - 4 * g));
    const bool m0 = (4 * g + 0) <= i, m1 = (4 * g + 1) <= i, m2 = (4 * g + 2) <= i, m3 = (4 * g + 3) <= i;
    f32x4 S[16];
#pragma unroll
    for (int kt = 0; kt < 16; ++kt) {
        if (kt <= wt) {
            f32x4 s = st_tile(Kt, kt * 16, qf, c.lane);
            s[0] *= Ekt; s[1] *= Ekt * F1; s[2] *= Ekt * F2; s[3] *= Ekt * F3;
            if (kt == wt) { s[0] = m0 ? s[0] : 0.f; s[1] = m1 ? s[1] : 0.f; s[2] = m2 ? s[2] : 0.f; s[3] = m3 ? s[3] : 0.f; }
            S[kt] = s;
            Ekt *= c16;
        } else S[kt] = (f32x4){0.f, 0.f, 0.f, 0.f};
    }
    f32x4 O[4];
#pragma unroll
    for (int et = 0; et < 4; ++et) O[et] = (f32x4){0.f, 0.f, 0.f, 0.f};
#pragma unroll
    for (int s = 0; s < 8; ++s) if (2 * s <= wt) pv_step(Vt, 32 * s, S[2 * s], S[2 * s + 1], O, c.lane);
    f32x4 X[4];
    cross_state((const bf16_t*)(a.ws + WS_RPREV) + ((size_t)h * 64 + ch) * 4096, qf, X, c.lane);
    const float xi = exp2f(lg2g * (float)(ql + 1));
#pragma unroll
    for (int et = 0; et < 4; ++et) O[et] += X[et] * xi;
    headnorm_store(O, a.ret_nw + (size_t)l * 256 + h * 64, proj + (size_t)t * NP + C_BG + h * 64, c.lane);
}
__device__ __forceinline__ void ret_x3_unit(const Ctx& c, const Args& a, int l, int h, int ch) {
    const float lg2g = log2f(1.f - exp2f(-5.f - (float)h));
    ret_stage<false>(c, a, h, ch * 256, lg2g);
    __syncthreads();
    ret_x3_tile(c, a, l, h, ch, c.wave, lg2g);
    ret_x3_tile(c, a, l, h, ch, 15 - c.wave, lg2g);
    __syncthreads();
}

__device__ __forceinline__ void conv8(const bf16_t* proj, const float* cw, const float* cb, int col, int cch, int t, float (&out)[8]) {
    float acc[8];
    { const f32x4 b0 = *(const f32x4*)(cb + cch), b1 = *(const f32x4*)(cb + cch + 4);
      acc[0] = b0[0]; acc[1] = b0[1]; acc[2] = b0[2]; acc[3] = b0[3]; acc[4] = b1[0]; acc[5] = b1[1]; acc[6] = b1[2]; acc[7] = b1[3]; }
#pragma unroll
    for (int tap = 0; tap < 4; ++tap) {
        const int tt = t - 3 + tap;
        if (tt >= 0) {
            float x[8]; load8f(proj + (size_t)tt * NP + col, x);
            const f32x4 w0 = *(const f32x4*)(cw + tap * 512 + cch), w1 = *(const f32x4*)(cw + tap * 512 + cch + 4);
            acc[0] = fmaf(w0[0], x[0], acc[0]); acc[1] = fmaf(w0[1], x[1], acc[1]); acc[2] = fmaf(w0[2], x[2], acc[2]); acc[3] = fmaf(w0[3], x[3], acc[3]);
            acc[4] = fmaf(w1[0], x[4], acc[4]); acc[5] = fmaf(w1[1], x[5], acc[5]); acc[6] = fmaf(w1[2], x[6], acc[6]); acc[7] = fmaf(w1[3], x[7], acc[7]);
        }
    }
#pragma unroll
    for (int j = 0; j < 8; ++j) out[j] = siluf(acc[j]);
}
__device__ __forceinline__ void ml_gates(const Ctx& c, const Args& a, int l, int h, int T0, LAS float* sb, LAS float* si) {
    const float* gates = (const float*)(a.ws + WS_GATES);
    if (c.tid < 128) {
        const int t = T0 + c.tid;
        const float f = gates[(size_t)t * 8 + 4 + h] + a.gate_bias[l * 8 + 4 + h];
        sb[c.tid] = fminf(f, 0.f) - log1pf(__expf(-fabsf(f)));
        si[c.tid] = gates[(size_t)t * 8 + h] + a.gate_bias[l * 8 + h];
    }
    __syncthreads();
    if (c.wave == 0) {
        const float v0 = sb[2 * c.lane], v1 = sb[2 * c.lane + 1];
        float s = v0 + v1;
#pragma unroll
        for (int o = 1; o < 64; o <<= 1) { const float n = __shfl_up(s, o); if (c.lane >= o) s += n; }
        const float excl = s - (v0 + v1);
        sb[2 * c.lane] = excl + v0; sb[2 * c.lane + 1] = excl + v0 + v1;
    }
    __syncthreads();
}
__device__ __forceinline__ void ml_stage(const Ctx& c, const Args& a, int l, int h, int T0, const LAS float* wrow) {
    const bf16_t* proj = (const bf16_t*)(a.ws + WS_PROJ);
    const float* cw = a.conv_w + (size_t)l * 4 * 512; const float* cb = a.conv_b + (size_t)l * 512;
    LAS unsigned char* Kt = c.lds + LDS_KT; LAS unsigned char* Vt = c.lds + LDS_VT;
    for (int it = c.tid; it < 128 * 8; it += NTHREADS) {
        const int row = it >> 3, c16 = it & 7;
        float k8[8]; conv8(proj, cw, cb, C_CK + h * 64 + 8 * c16, 256 + h * 64 + 8 * c16, T0 + row, k8);
        const float sc = wrow ? 0.125f * wrow[row] : 0.125f;
#pragma unroll
        for (int j = 0; j < 8; ++j) k8[j] *= sc;
        tile_store8(Kt, row, c16, k8);
        *(LAS u32x4*)(Vt + TILE_OFF(row, c16)) = *(const u32x4*)(proj + (size_t)(T0 + row) * NP + C_CV + h * 64 + 8 * c16);
    }
}
__device__ __forceinline__ void ml_x1_unit(const Ctx& c, const Args& a, int l, int h, int ch) {
    LAS float* sb = (LAS float*)(c.lds + LDS_SCR); LAS float* si = sb + 128; LAS float* sw = sb + 256; LAS float* red = sb + 384;
    const int T0 = ch * 128;
    ml_gates(c, a, l, h, T0, sb, si);
    if (c.wave == 0) {
        const float bl = sb[127];
        const float g0 = bl - sb[2 * c.lane] + si[2 * c.lane], g1 = bl - sb[2 * c.lane + 1] + si[2 * c.lane + 1];
        float m = fmaxf(g0, g1);
#pragma unroll
        for (int o = 1; o < 64; o <<= 1) m = fmaxf(m, __shfl_xor(m, o));
        sw[2 * c.lane] = __expf(g0 - m); sw[2 * c.lane + 1] = __expf(g1 - m);
        if (c.lane == 0) { ((float*)(a.ws + WS_MLOC))[h * 128 + ch] = m; ((float*)(a.ws + WS_BC))[h * 128 + ch] = bl; }
    }
    __syncthreads();
    ml_stage(c, a, l, h, T0, sw);
    __syncthreads();
    kvt_mfma<128>(c, (float*)(a.ws + WS_KVML) + ((size_t)h * 128 + ch) * 4096);
    {
        LAS unsigned char* Kt = c.lds + LDS_KT;
        const int d = c.tid & 63, part = c.tid >> 6;
        float s = 0.f;
#pragma unroll
        for (int r = 0; r < 16; ++r) { const int row = part * 16 + r; s += bf2f(*(const LAS bf16_t*)(Kt + TILE_OFF(row, d >> 3) + (d & 7) * 2)); }
        red[part * 64 + d] = s;
    }
    __syncthreads();
    if (c.tid < 64) { float s = 0.f;
#pragma unroll
        for (int p = 0; p < 8; ++p) s += red[p * 64 + c.tid];
        ((float*)(a.ws + WS_NLOC))[((size_t)h * 128 + ch) * 64 + c.tid] = s; }
    __syncthreads();
}
__device__ __forceinline__ void ml_x3_unit(const Ctx& c, const Args& a, int l, int h, int ch) {
    LAS float* sb = (LAS float*)(c.lds + LDS_SCR); LAS float* si = sb + 128; LAS float* su = sb + 256; LAS float* sM = sb + 384; LAS float* sn = sb + 512;
    bf16_t* proj = (bf16_t*)(a.ws + WS_PROJ);
    const int T0 = ch * 128;
    const float m_st = ((const float*)(a.ws + WS_MPREV))[h * 128 + ch];
    ml_gates(c, a, l, h, T0, sb, si);
    if (c.wave == 0) {
        const float u0 = si[2 * c.lane] - sb[2 * c.lane], u1 = si[2 * c.lane + 1] - sb[2 * c.lane + 1];
        float m = fmaxf(u0, u1);
#pragma unroll
        for (int o = 1; o < 64; o <<= 1) { const float n = __shfl_up(m, o); if (c.lane >= o) m = fmaxf(m, n); }
        float mprev = __shfl_up(m, 1); if (c.lane == 0) mprev = -INFINITY;
        su[2 * c.lane] = u0; su[2 * c.lane + 1] = u1;
        sM[2 * c.lane] = fmaxf(m_st, fmaxf(mprev, u0)); sM[2 * c.lane + 1] = fmaxf(m_st, m);
    }
    if (c.wave == 1) sn[c.lane] = ((const float*)(a.ws + WS_NPREV))[((size_t)h * 128 + ch) * 64 + c.lane];
    ml_stage(c, a, l, h, T0, nullptr);
    __syncthreads();
    {
        LAS unsigned char* Kt = c.lds + LDS_KT; LAS unsigned char* Vt = c.lds + LDS_VT;
        const int wt = c.wave, i = c.lane & 15, g = c.lane >> 4, ql = wt * 16 + i, t = T0 + ql;
        const float* cw = a.conv_w + (size_t)l * 4 * 512; const float* cb = a.conv_b + (size_t)l * 512;
        bf16x8 qf[2]; float qn;
        {
            float q0[8], q1[8];
            conv8(proj, cw, cb, C_CQ + h * 64 + 8 * g, h * 64 + 8 * g, t, q0); conv8(proj, cw, cb, C_CQ + h * 64 + 32 + 8 * g, h * 64 + 32 + 8 * g, t, q1);
            qf[0] = __builtin_bit_cast(bf16x8, pack8(q0)); qf[1] = __builtin_bit_cast(bf16x8, pack8(q1));
            float s = 0.f;
#pragma unroll
            for (int j = 0; j < 8; ++j) s += q0[j] * sn[8 * g + j] + q1[j] * sn[32 + 8 * g + j];
            qn = grp4_sum(s);
        }
        const float Mq = sM[ql];
        const bool m0 = (4 * g + 0) <= i, m1 = (4 * g + 1) <= i, m2 = (4 * g + 2) <= i, m3 = (4 * g + 3) <= i;
        f32x4 S[8]; float rs = 0.f;
#pragma unroll
        for (int kt = 0; kt < 8; ++kt) {
            if (kt <= wt) {
                f32x4 s = st_tile(Kt, kt * 16, qf, c.lane);
                const f32x4 u4 = *(const LAS f32x4*)(su + kt * 16 + 4 * g);
                s[0] *= __expf(u4[0] - Mq); s[1] *= __expf(u4[1] - Mq); s[2] *= __expf(u4[2] - Mq); s[3] *= __expf(u4[3] - Mq);
                if (kt == wt) { s[0] = m0 ? s[0] : 0.f; s[1] = m1 ? s[1] : 0.f; s[2] = m2 ? s[2] : 0.f; s[3] = m3 ? s[3] : 0.f; }
                rs += (s[0] + s[1]) + (s[2] + s[3]);
                S[kt] = s;
            } else S[kt] = (f32x4){0.f, 0.f, 0.f, 0.f};
        }
        rs = grp4_sum(rs);
        f32x4 O[4];
#pragma unroll
        for (int et = 0; et < 4; ++et) O[et] = (f32x4){0.f, 0.f, 0.f, 0.f};
#pragma unroll
        for (int s = 0; s < 4; ++s) if (2 * s <= wt) pv_step(Vt, 32 * s, S[2 * s], S[2 * s + 1], O, c.lane);
        f32x4 X[4];
        cross_state((const bf16_t*)(a.ws + WS_CPREV) + ((size_t)h * 128 + ch) * 4096, qf, X, c.lane);
        const float winter = __expf(m_st - Mq);
        const float den = rs + winter * qn;
        const float inv = 1.f / fmaxf(fabsf(den), __expf(-(sb[ql] + Mq)));
#pragma unroll
        for (int et = 0; et < 4; ++et) {
            const uint2 ow = *(const uint2*)(proj + (size_t)t * NP + C_CO + h * 64 + et * 16 + 4 * g);
            const float o0 = __uint_as_float(ow.x << 16), o1 = __uint_as_float(ow.x & 0xffff0000u), o2 = __uint_as_float(ow.y << 16), o3 = __uint_as_float(ow.y & 0xffff0000u);
            f32x4 hv = (O[et] + X[et] * winter) * inv;
            hv[0] *= sigmf(o0); hv[1] *= sigmf(o1); hv[2] *= sigmf(o2); hv[3] *= sigmf(o3);
            O[et] = hv;
        }
        headnorm_store(O, a.ml_nw + (size_t)l * 256 + h * 64, proj + (size_t)t * NP + C_CG + h * 64, c.lane);
    }
    __syncthreads();
}

__device__ __forceinline__ void ret_scan_unit(const Ctx& c, const Args& a, int h, int part) {
    const float* kv = (const float*)(a.ws + WS_KVRET) + (size_t)h * 64 * 4096 + part * 512 + c.tid;
    bf16_t* rp = (bf16_t*)(a.ws + WS_RPREV) + (size_t)h * 64 * 4096 + part * 512 + c.tid;
    const float dec = exp2f(256.f * log2f(1.f - exp2f(-5.f - (float)h)));
    float st = 0.f;
    for (int c0 = 0; c0 < 64; c0 += 8) {
        float v[8];
#pragma unroll
        for (int j = 0; j < 8; ++j) v[j] = kv[(size_t)(c0 + j) * 4096];
#pragma unroll
        for (int j = 0; j < 8; ++j) { rp[(size_t)(c0 + j) * 4096] = f2bf(st); st = fmaf(dec, st, v[j]); }
    }
}
__device__ __forceinline__ void ml_scan_unit(const Ctx& c, const Args& a, int h, int part) {
    LAS float* sa = (LAS float*)(c.lds + LDS_SCR); LAS float* swl = sa + 128;
    const float* mloc = (const float*)(a.ws + WS_MLOC) + h * 128; const float* bc = (const float*)(a.ws + WS_BC) + h * 128;
    if (c.tid == 0) {
        float m = 0.f;
        for (int ch = 0; ch < 128; ++ch) {
            if (part == 0) ((float*)(a.ws + WS_MPREV))[h * 128 + ch] = m;
            const float B = bc[ch], ml = mloc[ch];
            const float mn = fmaxf(B + m, ml);
            sa[ch] = __expf(B + m - mn); swl[ch] = __expf(ml - mn);
            m = mn;
        }
    }
    __syncthreads();
    const int idx = part * 512 + c.tid;
    if (idx < 4160) {
        const bool isC = idx < 4096;
        const float* src = isC ? (const float*)(a.ws + WS_KVML) + (size_t)h * 128 * 4096 + idx : (const float*)(a.ws + WS_NLOC) + (size_t)h * 128 * 64 + (idx - 4096);
        const size_t sstride = isC ? 4096 : 64;
        bf16_t* cp = (bf16_t*)(a.ws + WS_CPREV) + (size_t)h * 128 * 4096 + idx;
        float* np = (float*)(a.ws + WS_NPREV) + (size_t)h * 128 * 64 + (idx - 4096);
        float st = 0.f;
        for (int c0 = 0; c0 < 128; c0 += 8) {
            float v[8];
#pragma unroll
            for (int j = 0; j < 8; ++j) v[j] = src[(size_t)(c0 + j) * sstride];
#pragma unroll
            for (int j = 0; j < 8; ++j) {
                if (isC) cp[(size_t)(c0 + j) * 4096] = f2bf(st); else np[(size_t)(c0 + j) * 64] = st;
                st = sa[c0 + j] * st + swl[c0 + j] * v[j];
            }
        }
    }
    __syncthreads();
}

#define CW_CNT(l) (4096 + (l) * 512)
#define MOBA_C1 0.18033688011112042f
__device__ __forceinline__ int list_off(int n) { return 16384 * n - 128 * n * (n + 1); }
__device__ __forceinline__ bool better(float v, int n, float w, int m) { return v > w || (v == w && n < m); }
__device__ __forceinline__ void top3_insert(float v, int n, float& v0, int& i0, float& v1, int& i1, float& v2, int& i2) {
    const bool b0 = better(v, n, v0, i0), b1 = better(v, n, v1, i1), b2 = better(v, n, v2, i2);
    const float nv2 = b1 ? v1 : (b2 ? v : v2); const int ni2 = b1 ? i1 : (b2 ? n : i2);
    const float nv1 = b0 ? v0 : (b1 ? v : v1); const int ni1 = b0 ? i0 : (b1 ? n : i1);
    const float nv0 = b0 ? v : v0;             const int ni0 = b0 ? n : i0;
    v0 = nv0; i0 = ni0; v1 = nv1; i1 = ni1; v2 = nv2; i2 = ni2;
}
__device__ __forceinline__ void load_qf(const bf16_t* qrow, bf16x8 (&qf)[2], int g) { qf[0] = *(const bf16x8*)(qrow + 8 * g); qf[1] = *(const bf16x8*)(qrow + 32 + 8 * g); }

__device__ __forceinline__ void moba_gate_unit(const Ctx& c, const Args& a, int l, int h, int qc) {
    const int j = qc >> 1;
    if (j == 0) return;
    const bf16_t* proj = (const bf16_t*)(a.ws + WS_PROJ); const float* kmp = (const float*)(a.ws + WS_KMP);
    LAS unsigned char* KM = c.lds + LDS_KT;
    LAS unsigned* hist = (LAS unsigned*)(c.lds + LDS_SCR); LAS unsigned* base = hist + 64;
    unsigned* gcnt = (unsigned*)(a.ws + WS_CTL) + CW_CNT(l) + h * 64;
    unsigned* list = (unsigned*)(a.ws + WS_LIST) + (size_t)h * LIST_PER_HEAD;
    for (int it = c.tid; it < 64 * 8; it += NTHREADS) {
        const int n = it >> 3, c16 = it & 7;
        const float* p0 = kmp + (size_t)(2 * n) * 512 + h * 64 + 8 * c16; const float* p1 = p0 + 512;
        const f32x4 a0 = *(const f32x4*)p0, a1 = *(const f32x4*)(p0 + 4), b0 = *(const f32x4*)p1, b1 = *(const f32x4*)(p1 + 4);
        float v[8];
#pragma unroll
        for (int q = 0; q < 4; ++q) { v[q] = (a0[q] + b0[q]) * (1.f / 256.f); v[4 + q] = (a1[q] + b1[q]) * (1.f / 256.f); }
        tile_store8(KM, n, c16, v);
    }
    if (c.tid < 64) hist[c.tid] = 0u;
    __syncthreads();
    const int i = c.lane & 15, g = c.lane >> 4, t = qc * 128 + c.wave * 16 + i;
    bf16x8 qf[2]; load_qf(proj + (size_t)t * NP + C_AQ + h * 64, qf, g);
    float v0 = -INFINITY, v1 = -INFINITY, v2 = -INFINITY; int i0 = 0, i1 = 0, i2 = 0;
#pragma unroll
    for (int nt = 0; nt < 4; ++nt) {
        if (nt * 16 < j) {
            const f32x4 gt = st_tile(KM, nt * 16, qf, c.lane);
#pragma unroll
            for (int r = 0; r < 4; ++r) { const int n = nt * 16 + 4 * g + r; top3_insert(n < j ? gt[r] : -INFINITY, n, v0, i0, v1, i1, v2, i2); }
        }
    }
#pragma unroll
    for (int off = 16; off <= 32; off <<= 1) {
        const float p0 = __shfl_xor(v0, off), p1 = __shfl_xor(v1, off), p2 = __shfl_xor(v2, off);
        const int q0 = __shfl_xor(i0, off), q1 = __shfl_xor(i1, off), q2 = __shfl_xor(i2, off);
        top3_insert(p0, q0, v0, i0, v1, i1, v2, i2); top3_insert(p1, q1, v0, i0, v1, i1, v2, i2); top3_insert(p2, q2, v0, i0, v1, i1, v2, i2);
    }
    const int nsel = j < 3 ? j : 3;
    const bool valid = g < nsel;
    const int n = g == 0 ? i0 : (g == 1 ? i1 : i2);
    unsigned pos = 0u;
    if (valid) pos = __hip_atomic_fetch_add(hist + n, 1u, __ATOMIC_RELAXED, __HIP_MEMORY_SCOPE_WORKGROUP);
    __syncthreads();
    if (c.tid < 64) { const unsigned cn = hist[c.tid]; base[c.tid] = cn ? __hip_atomic_fetch_add(gcnt + c.tid, cn, __ATOMIC_RELAXED, __HIP_MEMORY_SCOPE_AGENT) : 0u; }
    __syncthreads();
    if (valid) list[list_off(n) + base[n] + pos] = (unsigned)(t * 4 + g);
    __syncthreads();
}

__device__ __forceinline__ void moba_stage_kv(const Ctx& c, const Args& a, int h, int n) {
    const bf16_t* proj = (const bf16_t*)(a.ws + WS_PROJ);
    LAS unsigned char* Kt = c.lds + LDS_KT; LAS unsigned char* Vt = c.lds + LDS_VT;
    for (int it = c.tid; it < 256 * 8; it += NTHREADS) {
        const int row = it >> 3, c16 = it & 7;
        const bf16_t* rp = proj + (size_t)(n * 256 + row) * NP + h * 64 + 8 * c16;
        *(LAS u32x4*)(Kt + TILE_OFF(row, c16)) = *(const u32x4*)(rp + C_AK);
        *(LAS u32x4*)(Vt + TILE_OFF(row, c16)) = *(const u32x4*)(rp + C_AV);
    }
}
__device__ __forceinline__ void moba_sel_tile(const Ctx& c, const Args& a, int h, int n, int tile, unsigned cnt) {
    const bf16_t* proj = (const bf16_t*)(a.ws + WS_PROJ);
    LAS unsigned char* Kt = c.lds + LDS_KT; LAS unsigned char* Vt = c.lds + LDS_VT;
    const unsigned* list = (const unsigned*)(a.ws + WS_LIST) + (size_t)h * LIST_PER_HEAD + list_off(n);
    moba_stage_kv(c, a, h, n);
    __syncthreads();
    const int i = c.lane & 15, g = c.lane >> 4;
    const unsigned e = (unsigned)(tile * 128 + c.wave * 16 + i);
    const bool valid = e < cnt;
    const unsigned entry = list[valid ? e : (unsigned)(tile * 128)];
    const int t = (int)(entry >> 2), slot = (int)(entry & 3u);
    bf16x8 qf[2]; load_qf(proj + (size_t)t * NP + C_AQ + h * 64, qf, g);
    const float sl2 = exp2f(-(float)(h + 1)) * 1.4426950408889634f;
    const float zb = sl2 * (float)(n * 256 + 4 * g - t);
    f32x4 S[16]; float m = -INFINITY;
#pragma unroll
    for (int kt = 0; kt < 16; ++kt) {
        f32x4 s = st_tile(Kt, kt * 16, qf, c.lane);
        const float zk = zb + sl2 * (float)(16 * kt);
        s[0] = fmaf(s[0], MOBA_C1, zk); s[1] = fmaf(s[1], MOBA_C1, zk + sl2); s[2] = fmaf(s[2], MOBA_C1, zk + 2.f * sl2); s[3] = fmaf(s[3], MOBA_C1, zk + 3.f * sl2);
        m = fmaxf(m, fmaxf(fmaxf(s[0], s[1]), fmaxf(s[2], s[3])));
        S[kt] = s;
    }
    m = grp4_max(m);
    float ls = 0.f;
#pragma unroll
    for (int kt = 0; kt < 16; ++kt) {
        f32x4 s = S[kt];
        s[0] = exp2f(s[0] - m); s[1] = exp2f(s[1] - m); s[2] = exp2f(s[2] - m); s[3] = exp2f(s[3] - m);
        ls += (s[0] + s[1]) + (s[2] + s[3]);
        S[kt] = s;
    }
    ls = grp4_sum(ls);
    f32x4 O[4];
#pragma unroll
    for (int et = 0; et < 4; ++et) O[et] = (f32x4){0.f, 0.f, 0.f, 0.f};
#pragma unroll
    for (int s = 0; s < 8; ++s) pv_step(Vt, 32 * s, S[2 * s], S[2 * s + 1], O, c.lane);
    if (valid) {
        const float inv = 1.f / ls;
        const size_t pidx = ((size_t)t * 8 + h) * 3 + slot;
        bf16_t* po = (bf16_t*)(a.ws + WS_PART) + pidx * 64;
#pragma unroll
        for (int et = 0; et < 4; ++et) { uint2 o; o.x = pk2(O[et][0] * inv, O[et][1] * inv); o.y = pk2(O[et][2] * inv, O[et][3] * inv); *(uint2*)(po + et * 16 + 4 * g) = o; }
        if (g == 0) *(float2*)((float*)(a.ws + WS_PML) + pidx * 2) = make_float2(m, ls);
    }
    __syncthreads();
}
__device__ __forceinline__ void moba_own_tile(const Ctx& c, const Args& a, int h, int j, int wt) {
    bf16_t* proj = (bf16_t*)(a.ws + WS_PROJ);
    LAS unsigned char* Kt = c.lds + LDS_KT; LAS unsigned char* Vt = c.lds + LDS_VT;
    const int i = c.lane & 15, g = c.lane >> 4, ql = wt * 16 + i, t = j * 256 + ql;
    bf16x8 qf[2]; load_qf(proj + (size_t)t * NP + C_AQ + h * 64, qf, g);
    const float sl2 = exp2f(-(float)(h + 1)) * 1.4426950408889634f;
    const float zb = sl2 * (float)(4 * g - ql);
    const bool m0 = (4 * g + 0) <= i, m1 = (4 * g + 1) <= i, m2 = (4 * g + 2) <= i, m3 = (4 * g + 3) <= i;
    f32x4 S[16]; float m = -INFINITY;
#pragma unroll
    for (int kt = 0; kt < 16; ++kt) {
        if (kt <= wt) {
            f32x4 s = st_tile(Kt, kt * 16, qf, c.lane);
            const float zk = zb + sl2 * (float)(16 * kt);
            s[0] = fmaf(s[0], MOBA_C1, zk); s[1] = fmaf(s[1], MOBA_C1, zk + sl2); s[2] = fmaf(s[2], MOBA_C1, zk + 2.f * sl2); s[3] = fmaf(s[3], MOBA_C1, zk + 3.f * sl2);
            if (kt == wt) { s[0] = m0 ? s[0] : -INFINITY; s[1] = m1 ? s[1] : -INFINITY; s[2] = m2 ? s[2] : -INFINITY; s[3] = m3 ? s[3] : -INFINITY; }
            m = fmaxf(m, fmaxf(fmaxf(s[0], s[1]), fmaxf(s[2], s[3])));
            S[kt] = s;
        } else S[kt] = (f32x4){-INFINITY, -INFINITY, -INFINITY, -INFINITY};
    }
    m = grp4_max(m);
    float ls = 0.f;
#pragma unroll
    for (int kt = 0; kt < 16; ++kt) {
        f32x4 s = S[kt];
        if (kt <= wt) { s[0] = exp2f(s[0] - m); s[1] = exp2f(s[1] - m); s[2] = exp2f(s[2] - m); s[3] = exp2f(s[3] - m); ls += (s[0] + s[1]) + (s[2] + s[3]); }
        else s = (f32x4){0.f, 0.f, 0.f, 0.f};
        S[kt] = s;
    }
    ls = grp4_sum(ls);
    f32x4 O[4];
#pragma unroll
    for (int et = 0; et < 4; ++et) O[et] = (f32x4){0.f, 0.f, 0.f, 0.f};
#pragma unroll
    for (int s = 0; s < 8; ++s) if (2 * s <= wt) pv_step(Vt, 32 * s, S[2 * s], S[2 * s + 1], O, c.lane);
    const int nsel = j < 3 ? j : 3;
    const size_t pbase = ((size_t)t * 8 + h) * 3;
    const float2* pml = (const float2*)((const float*)(a.ws + WS_PML)) + pbase;
    float2 ml0 = make_float2(-INFINITY, 0.f), ml1 = ml0, ml2 = ml0;
    if (nsel > 0) ml0 = pml[0];
    if (nsel > 1) ml1 = pml[1];
    if (nsel > 2) ml2 = pml[2];
    const float mt = fmaxf(fmaxf(m, ml0.x), fmaxf(ml1.x, ml2.x));
    const float aown = exp2f(m - mt);
    const float a0 = nsel > 0 ? exp2f(ml0.x - mt) * ml0.y : 0.f, a1 = nsel > 1 ? exp2f(ml1.x - mt) * ml1.y : 0.f, a2 = nsel > 2 ? exp2f(ml2.x - mt) * ml2.y : 0.f;
    const float inv = 1.f / (ls * aown + a0 + a1 + a2);
    const bf16_t* po = (const bf16_t*)(a.ws + WS_PART) + pbase * 64;
#pragma unroll
    for (int et = 0; et < 4; ++et) {
        const int e = et * 16 + 4 * g;
        f32x4 o = O[et] * aown;
        if (nsel > 0) { const uint2 w = *(const uint2*)(po + e); o[0] += a0 * __uint_as_float(w.x << 16); o[1] += a0 * __uint_as_float(w.x & 0xffff0000u); o[2] += a0 * __uint_as_float(w.y << 16); o[3] += a0 * __uint_as_float(w.y & 0xffff0000u); }
        if (nsel > 1) { const uint2 w = *(const uint2*)(po + 64 + e); o[0] += a1 * __uint_as_float(w.x << 16); o[1] += a1 * __uint_as_float(w.x & 0xffff0000u); o[2] += a1 * __uint_as_float(w.y << 16); o[3] += a1 * __uint_as_float(w.y & 0xffff0000u); }
        if (nsel > 2) { const uint2 w = *(const uint2*)(po + 128 + e); o[0] += a2 * __uint_as_float(w.x << 16); o[1] += a2 * __uint_as_float(w.x & 0xffff0000u); o[2] += a2 * __uint_as_float(w.y << 16); o[3] += a2 * __uint_as_float(w.y & 0xffff0000u); }
        bf16_t* gp = proj + (size_t)t * NP + C_AG + h * 64 + e;
        const uint2 gw = *(const uint2*)gp;
        uint2 ow;
        ow.x = pk2(o[0] * inv * siluf(__uint_as_float(gw.x << 16)), o[1] * inv * siluf(__uint_as_float(gw.x & 0xffff0000u)));
        ow.y = pk2(o[2] * inv * siluf(__uint_as_float(gw.y << 16)), o[3] * inv * siluf(__uint_as_float(gw.y & 0xffff0000u)));
        *(uint2*)gp = ow;
    }
}
__device__ __forceinline__ void moba_own_unit(const Ctx& c, const Args& a, int h, int j) {
    moba_stage_kv(c, a, h, j);
    __syncthreads();
    moba_own_tile(c, a, h, j, c.wave);
    moba_own_tile(c, a, h, j, 15 - c.wave);
    __syncthreads();
}
__device__ __forceinline__ void moba_sel_phase(const Ctx& c, const Args& a, int l) {
    LAS unsigned* pre = (LAS unsigned*)(c.lds + LDS_SCR + 8192);
    const unsigned* gcnt = (const unsigned*)(a.ws + WS_CTL) + CW_CNT(l);
    const unsigned cntp = __hip_atomic_load(gcnt + c.tid, __ATOMIC_RELAXED, __HIP_MEMORY_SCOPE_AGENT);
    unsigned v = (cntp + 127u) >> 7;
#pragma unroll
    for (int o = 1; o < 64; o <<= 1) { const unsigned nb = __shfl_up(v, o); if (c.lane >= o) v += nb; }
    if (c.lane == 63) pre[512 + c.wave] = v;
    __syncthreads();
    unsigned woff = 0;
    for (int w = 0; w < c.wave; ++w) woff += pre[512 + w];
    pre[c.tid] = v + woff;
    __syncthreads();
    const unsigned T = pre[511];
    for (unsigned u = (unsigned)(c.G - 1 - c.bid); u < T; u += (unsigned)c.G) {
        int lo = 0, hi = 511;
        while (lo < hi) { const int mid = (lo + hi) >> 1; if (pre[mid] > u) hi = mid; else lo = mid + 1; }
        const int pair = lo; const unsigned before = pair ? pre[pair - 1] : 0u;
        const unsigned cn = __hip_atomic_load(gcnt + pair, __ATOMIC_RELAXED, __HIP_MEMORY_SCOPE_AGENT);
        moba_sel_tile(c, a, pair >> 6, pair & 63, (int)(u - before), cn);
    }
    __syncthreads();
}
__device__ __forceinline__ void phase_pb(const Ctx& c, const Args& a, int l) {
    if (l + 1 < DEPTH) convert_w_in(c, a, l + 1);
    if (l >= 1) convert_w_out(c, a, l);
    __syncthreads();
    for (int u = c.bid; u < 256 + 512 + 1024; u += c.G) {
        if (u < 256) ret_x1_unit(c, a, u >> 6, u & 63);
        else if (u < 768) ml_x1_unit(c, a, l, (u - 256) >> 7, (u - 256) & 127);
        else moba_gate_unit(c, a, l, (u - 768) >> 7, (u - 768) & 127);
    }
}
__device__ __forceinline__ void phase_pc(const Ctx& c, const Args& a, int l) {
    for (int u = c.bid; u < 32 + 36; u += c.G) {
        if (u < 32) ret_scan_unit(c, a, u >> 3, u & 7);
        else ml_scan_unit(c, a, (u - 32) / 9, (u - 32) % 9);
    }
    moba_sel_phase(c, a, l);
}
__device__ __forceinline__ void phase_pd(const Ctx& c, const Args& a, int l) {
    for (int u = c.bid; u < 512 + 256 + 512; u += c.G) {
        if (u < 512) moba_own_unit(c, a, u >> 6, u & 63);
        else if (u < 768) ret_x3_unit(c, a, l, (u - 512) >> 6, (u - 512) & 63);
        else ml_x3_unit(c, a, l, (u - 768) >> 7, (u - 768) & 127);
    }
}
__global__ void __launch_bounds__(NTHREADS, 2) mk(Args args) {
    extern __shared__ __attribute__((aligned(16))) unsigned char lds_raw[];
    LAS unsigned char* lds = (LAS unsigned char*)lds_raw;
    volatile LAS unsigned* MISC = (volatile LAS unsigned*)(lds + LDS_CTL_OFF);
    if (threadIdx.x < 64) MISC[threadIdx.x] = 0u;
    __syncthreads();
    XcdBarrier bar; bar.bar = (unsigned*)(args.ws + WS_CTL) + CW_BAR; bar.x = 0; bar.st = MISC + 8;
    const bool multi = (args.ph_hi - args.ph_lo) > 1;
    if (multi) bar = xcd_barrier_post((unsigned*)(args.ws + WS_CTL) + CW_BAR, MISC + 8);
    for (int ph = args.ph_lo; ph < args.ph_hi; ++ph) {
        int tid_ = threadIdx.x; asm volatile("" : "+v"(tid_));
        Ctx c; c.lds = lds; c.tid = tid_; c.lane = c.tid & 63; c.wave = __builtin_amdgcn_readfirstlane(c.tid >> 6); c.G = gridDim.x; c.bid = blockIdx.x;
        if (ph == 0) phase_p0(c, args);
        else if (ph < 21) {
            const int l = (ph - 1) / 5, s = (ph - 1) % 5;
            if (s == 0) phase_pa(c, args);
            else if (s == 1) phase_pb(c, args, l);
            else if (s == 2) phase_pc(c, args, l);
            else if (s == 3) phase_pd(c, args, l);
            else if (s == 4) phase_pe(c, args);
        }
        else if (ph == 21) phase_final(c, args);
        if (ph + 1 < args.ph_hi) xcd_barrier(bar);
    }
}

__global__ void k_kmean_from_kmp(const float* __restrict__ kmp, float* __restrict__ kmean) {
    int n = blockIdx.x, c = threadIdx.x;
    float s = kmp[(size_t)(n * 2) * 512 + c] + kmp[(size_t)(n * 2 + 1) * 512 + c];
    int h = c >> 6, d = c & 63;
    kmean[((size_t)h * 64 + n) * 64 + d] = s * (1.f / 256.f);
}
__global__ void k_xb_ssq(const float* __restrict__ xres, bf16_t* __restrict__ xb, float* __restrict__ ssqp) {
    int row = blockIdx.x * 4 + (threadIdx.x >> 6), lane = threadIdx.x & 63;
    xprep_row(xres + (size_t)row * DM, nullptr, xb + (size_t)row * DM, ssqp + (size_t)row * 4, lane);
}

extern "C" void kernel_launch(void* const* d_in, const int* in_sizes, int n_in, void* d_out, int out_size, void* d_ws, size_t ws_size, hipStream_t stream) {
    static bool attr = false;
    if (!attr) { (void)hipFuncSetAttribute((const void*)mk, hipFuncAttributeMaxDynamicSharedMemorySize, LDS_BYTES); attr = true; }
    Args a{};
    a.x = (const float*)d_in[0]; a.norm_w = (const float*)d_in[1]; a.w_in = (const float*)d_in[2]; a.conv_w = (const float*)d_in[3]; a.conv_b = (const float*)d_in[4];
    a.gate_bias = (const float*)d_in[5]; a.ret_nw = (const float*)d_in[6]; a.ml_nw = (const float*)d_in[7]; a.w_out = (const float*)d_in[8]; a.final_nw = (const float*)d_in[9];
    a.out = (float*)d_out; a.ws = (unsigned char*)d_ws;
    unsigned char* ws = (unsigned char*)d_ws;
    (void)hipMemsetAsync(ws + WS_CTL, 0, CTL_BYTES, stream);
    const int G = 256;
    auto run = [&](int lo, int hi) { a.ph_lo = lo; a.ph_hi = hi; hipLaunchKernelGGL(mk, dim3(G), dim3(NTHREADS), LDS_BYTES, stream, a); };
    bf16_t* proj = (bf16_t*)(ws + WS_PROJ); float* gates = (float*)(ws + WS_GATES); float* kmean = (float*)(ws + WS_KMEAN);
    float2* rope = (float2*)(ws + WS_ROPE); float* xres = (float*)d_out;
    run(0, 22);
}
```

```cpp
#include <hip/hip_runtime.h>
#include <stdint.h>

#define SEQ 16384
#define DM 1024
#define DEPTH 4
#define NIN 4360
#define NP 4352
#define MIXW 1024
#define C_AQ 0
#define C_AK 512
#define C_AV 1024
#define C_AG 1536
#define C_BQ 2048
#define C_BK 2304
#define C_BV 2560
#define C_BG 2816
#define C_CQ 3072
#define C_CK 3328
#define C_CV 3584
#define C_CO 3840
#define C_CG 4096

typedef unsigned short bf16_t;
__device__ __forceinline__ float bf2f(bf16_t b) { return __uint_as_float(((unsigned)b) << 16); }
__device__ __forceinline__ bf16_t f2bf(float f) { unsigned u = __float_as_uint(f); u += 0x7FFFu + ((u >> 16) & 1u); return (bf16_t)(u >> 16); }
__device__ __forceinline__ float sigmf(float x) { return __builtin_amdgcn_rcpf(1.f + __builtin_amdgcn_exp2f(-1.4426950408889634f * x)); }
__device__ __forceinline__ float siluf(float x) { return x * sigmf(x); }

__constant__ double c_theta[32] = {1, 0.74296395075949484, 0.55199543212815705, 0.41011270705513009, 0.30469895709035083, 0.22638034095214485, 0.16819243248808699, 0.12496091412919871, 0.092841454451947455, 0.06897785379387654, 0.051248058769609341, 0.038075460212223723, 0.028288694346259694, 0.021017480113324882, 0.015615230060004972, 0.011601553017399716, 0.0086195356647530315, 0.006404004271197283, 0.0047579443140094097, 0.0035349811050301057, 0.0026263635276533325, 0.0019512934226359642, 0.0014497406703726315, 0.0010771050560367691, 0.00080025022781610535, 0.0005945570708544394, 0.00044173447031400687, 0.0003281927872511474, 0.00024383540982688293, 0.00018116091942004152, 0.00013459603241553644, 0.0001};


#define WS_CTL      0ull
#define CTL_BYTES   65536ull
#define WS_WTIN     (WS_CTL + CTL_BYTES)
#define WS_WG       (WS_WTIN + 4352ull * 1024 * 2)
#define WS_WTOUT    (WS_WG + 8ull * 1024 * 4)
#define WS_ROPE     (WS_WTOUT + 1024ull * 1024 * 2)
#define WS_SSQP     (WS_ROPE + (size_t)SEQ * 32 * 8)
#define WS_PROJ     (WS_SSQP + (size_t)SEQ * 16)
#define WS_GATES    (WS_PROJ + (size_t)SEQ * NP * 2)
#define WS_KMP      (WS_GATES + (size_t)SEQ * 32)
#define WS_KMEAN    (WS_KMP + 64ull * 2 * 512 * 4)
#define WS_XB       (WS_KMEAN + 8ull * 64 * 64 * 4)
#define WS_END0     (WS_XB + (size_t)SEQ * DM * 2)

#define CW_BAR 0

#define LDS_CTL_OFF 131072
#ifdef PROBE_SUB
#ifndef PROBE_BLOCK
#define PROBE_BLOCK 200
#endif
#define PSUB_OK(c, id) ((id) == PROBE_SUB && (c).bid == PROBE_BLOCK && threadIdx.x == 0)
#define PSUB_T0(c, id) do { if (PSUB_OK(c, id)) { *(volatile LAS unsigned long long*)((LAS unsigned char*)0 + LDS_CTL_OFF + 128) = __builtin_amdgcn_s_memrealtime(); } } while (0)
#define PSUB_T1(c, id) do { if (PSUB_OK(c, id)) { volatile LAS unsigned long long* p_ = (volatile LAS unsigned long long*)((LAS unsigned char*)0 + LDS_CTL_OFF + 128); p_[1] += __builtin_amdgcn_s_memrealtime() - p_[0]; } } while (0)
#else
#define PSUB_T0(c, id) do { } while (0)
#define PSUB_T1(c, id) do { } while (0)
#endif
typedef short bf16x8 __attribute__((ext_vector_type(8)));
typedef float f32x4 __attribute__((ext_vector_type(4)));
typedef unsigned u32x4 __attribute__((ext_vector_type(4)));
#define GAS __attribute__((address_space(1)))
#define LAS __attribute__((address_space(3)))
#define LDS_WAIT() asm volatile("s_waitcnt lgkmcnt(0)" ::: "memory")
#define VM_WAIT() asm volatile("s_waitcnt vmcnt(0)" ::: "memory")
typedef float f32x2_t __attribute__((ext_vector_type(2)));
typedef __bf16 bf16x2_t __attribute__((ext_vector_type(2)));
__device__ __forceinline__ unsigned pk2(float lo, float hi) { const f32x2_t v = {lo, hi}; const bf16x2_t b = __builtin_convertvector(v, bf16x2_t); return __builtin_bit_cast(unsigned, b); }

#define XB_TMO      128
#define XB_XCNT(j)  (256  + 64 * (j))
#define XB_XSUB(j)  (1280 + 64 * (j))
#define XB_XGEN(j)  (2304 + 64 * (j))
#define XB_TOP      3328
#define XB_TOPGEN   3392
#define XCD_BAR_WORDS 3456
#define XB_SPIN_CAP (1u << 18)
__device__ __forceinline__ unsigned xb_ld(unsigned* p)              { return __hip_atomic_load(p, __ATOMIC_RELAXED, __HIP_MEMORY_SCOPE_AGENT); }
__device__ __forceinline__ unsigned xb_add(unsigned* p, unsigned v) { return __hip_atomic_fetch_add(p, v, __ATOMIC_RELAXED, __HIP_MEMORY_SCOPE_AGENT); }
__device__ __forceinline__ unsigned xb_xcc_id() { return (unsigned)__builtin_amdgcn_s_getreg((3 << 11) | 20) & 0xFu; }
#define XB_SPIN(cond, bar) do { unsigned _sp = 0; while (cond) { __builtin_amdgcn_s_sleep(1); \
    if ((++_sp & 255u) == 0u) { if (xb_ld(&(bar)[XB_TMO])) break; if (_sp > XB_SPIN_CAP) { atomicAdd(&(bar)[XB_TMO], 1u); break; } } } } while (0)
struct XcdBarrier { unsigned* bar; unsigned x; volatile LAS unsigned* st; };
__device__ __forceinline__ XcdBarrier xcd_barrier_post(unsigned* bar, volatile LAS unsigned* st) {
    XcdBarrier b; b.bar = bar; b.x = xb_xcc_id(); b.st = st;
    if (threadIdx.x == 0) (void)xb_add(&bar[XB_XCNT(b.x)], 1u);
    return b;
}
__device__ __forceinline__ void xcd_barrier_complete(unsigned* bar, unsigned x, unsigned& nloc, unsigned& nx) {
    const unsigned G = gridDim.x * gridDim.y * gridDim.z;
    unsigned sum, cnt, mine, sp = 0u;
    for (;;) {
        sum = 0u; cnt = 0u; mine = 0u;
#pragma unroll
        for (unsigned j = 0; j < 16; ++j) { const unsigned c = xb_ld(&bar[XB_XCNT(j)]); sum += c; cnt += (c > 0u) ? 1u : 0u; mine = (j == x) ? c : mine; }
        if (sum == G) break;
        __builtin_amdgcn_s_sleep(1);
        if ((++sp & 255u) == 0u) { if (xb_ld(&bar[XB_TMO])) break; if (sp > XB_SPIN_CAP) { atomicAdd(&bar[XB_TMO], 1u); break; } }
    }
    nloc = mine > 0u ? mine : 1u; nx = cnt > 0u ? cnt : 1u;
}
__device__ __forceinline__ void xcd_barrier(const XcdBarrier& b, bool t0  ) {
    asm volatile("s_waitcnt vmcnt(0)" ::: "memory");
    __syncthreads();
    if (t0) {
        unsigned* bar = b.bar;
        __builtin_amdgcn_s_waitcnt(0);
        unsigned nloc = b.st[0], nx = b.st[1];
        if (nloc == 0u) { xcd_barrier_complete(bar, b.x, nloc, nx); b.st[0] = nloc; b.st[1] = nx; }
        const unsigned old = xb_add(&bar[XB_XSUB(b.x)], 1u);
        const unsigned gen = old / nloc;
        if (old + 1u == (gen + 1u) * nloc) {
            __builtin_amdgcn_fence(__ATOMIC_RELEASE, "agent");
            asm volatile("s_waitcnt vmcnt(0)" ::: "memory");
            const unsigned og = xb_add(&bar[XB_TOP], 1u);
            const unsigned tg = og / nx;
            if (og + 1u == (tg + 1u) * nx) xb_add(&bar[XB_TOPGEN], 1u);
            else XB_SPIN(xb_ld(&bar[XB_TOPGEN]) == tg, bar);
            __builtin_amdgcn_fence(__ATOMIC_ACQUIRE, "agent");
            xb_add(&bar[XB_XGEN(b.x)], 1u);
            asm volatile("s_waitcnt vmcnt(0)" ::: "memory");
        } else {
            XB_SPIN(xb_ld(&bar[XB_XGEN(b.x)]) == gen, bar);
            __builtin_amdgcn_fence(__ATOMIC_ACQUIRE, "agent");
            asm volatile("s_waitcnt vmcnt(0)" ::: "memory");
        }
    }
    __syncthreads();
}

namespace pg8 {
#define PG8_LAS __attribute__((address_space(3)))
constexpr int BM = 256, BK = 64, HALF = 128, HTB = HALF * BK * 2  , STAGE_BYTES = 8 * HTB, NXCD = 8, WGM = 8;
__host__ __device__ __forceinline__ int lds_byte(int r, int c) { const int st = (r >> 4) * 2 + (c >> 5), rr = r & 15, cc = c & 31, ob = rr * 64 + cc * 2; return st * 1024 + (ob ^ (((ob >> 9) & 1) << 5)); }
__host__ __device__ __forceinline__ void stage_rc(int b, int& R, int& C) { const int st = b / 1024, sb = b % 1024, swz = sb ^ (((sb >> 9) & 1) << 5); R = (st >> 1) * 16 + swz / 64; C = (st & 1) * 32 + (swz % 64) / 2; }
__host__ __device__ __forceinline__ int perm32(int rho) { const int n = rho >> 4, i = rho & 15; return 8 * (i >> 2) + 4 * n + (i & 3); }
struct Unit { int pm, pn; };
struct Gemm { const bf16_t* A; const bf16_t* Bt; int M, N, K, lda; };
template <bool YG> __device__ __forceinline__ size_t koffA(int t) {
    if (!YG) return (size_t)t * (BK * 2);
    const int col = t < 8 ? C_AG + 64 * t : (t < 12 ? C_BG + 64 * (t - 8) : C_CG + 64 * (t - 12));
    return (size_t)col * 2;
}
struct StaticOrder {
    int nM, nN, nwg, G, c;
    __host__ __device__ void init(int M, int N, int G_, int c_) { nM = M / BM; nN = N / BM; nwg = nM * nN; G = G_; c = c_; }
    __host__ __device__ bool next(int i, Unit& u) const {
        const long L = (long)i * G + c; if (L >= nwg) return false;
        int wgid = (int)L; { const int q = nwg / NXCD, r = nwg % NXCD, xcd = wgid % NXCD, off = wgid / NXCD; wgid = (xcd < r ? xcd * (q + 1) : r * (q + 1) + (xcd - r) * q) + off; }
        const int nig = WGM * nN, gid = wgid / nig, fm = gid * WGM, gsz = (nM - fm) < WGM ? (nM - fm) : WGM;
        u.pm = fm + ((wgid % nig) % gsz); u.pn = (wgid % nig) / gsz; return true;
    }
    __device__ __forceinline__ void a_ready(const Unit&) const {}
    __device__ __forceinline__ void done(const Unit&) const {}
};
__device__ __forceinline__ unsigned cvt_pk_bf16(float lo, float hi) { return pk2(lo, hi); }

struct EpiProj {
    static constexpr bool PERM = true, AFTER_DRAIN = false;
    bf16_t* proj; const float* ssqp; float* kmp; int bid;
    __device__ __forceinline__ void operator()(const f32x4 (&acc)[2][2][4][2], const Unit& u, int wr, int wc, int fr, int fq) const {
        int row0 = u.pm * BM + wr * 64 + fr, col0 = u.pn * BM + wc * 32 + 8 * fq;
        asm volatile("" : "+v"(row0), "+v"(col0));
        const bool do_km = (u.pn == 2 || u.pn == 3);
        f32x4 cs[2][2];
#pragma unroll
        for (int bj = 0; bj < 2; ++bj)
#pragma unroll
            for (int n = 0; n < 2; ++n) cs[bj][n] = (f32x4){0.f, 0.f, 0.f, 0.f};
#pragma unroll
        for (int ai = 0; ai < 2; ++ai)
#pragma unroll
            for (int m = 0; m < 4; ++m) {
                const int r = row0 + ai * HALF + m * 16;
                const f32x4 s4 = *(const f32x4*)(ssqp + (size_t)r * 4);
                const float rs = rsqrtf(((s4[0] + s4[1]) + (s4[2] + s4[3])) * (1.0f / 1024.0f) + 1e-6f);
                bf16_t* rowp = proj + (size_t)r * NP + col0;
#pragma unroll
                for (int bj = 0; bj < 2; ++bj) {
                    const f32x4 v0 = acc[ai][bj][m][0] * rs, v1 = acc[ai][bj][m][1] * rs;
                    u32x4 w; w.x = cvt_pk_bf16(v0[0], v0[1]); w.y = cvt_pk_bf16(v0[2], v0[3]); w.z = cvt_pk_bf16(v1[0], v1[1]); w.w = cvt_pk_bf16(v1[2], v1[3]);
                    *(u32x4*)(rowp + bj * HALF) = w;
                    cs[bj][0] += v0; cs[bj][1] += v1;
                }
            }
        if (do_km) {
#pragma unroll
            for (int bj = 0; bj < 2; ++bj)
#pragma unroll
                for (int n = 0; n < 2; ++n)
#pragma unroll
                    for (int i = 0; i < 4; ++i) {
                        float v = cs[bj][n][i];
                        v += __shfl_xor(v, 1); v += __shfl_xor(v, 2); v += __shfl_xor(v, 4); v += __shfl_xor(v, 8);
                        cs[bj][n][i] = v;
                    }
            if (fr == 0) {
                float* kp = kmp + (size_t)(u.pm * 2 + wr) * 512 + (col0 - C_AK);
#pragma unroll
                for (int bj = 0; bj < 2; ++bj) { *(f32x4*)(kp + bj * HALF) = cs[bj][0]; *(f32x4*)(kp + bj * HALF + 4) = cs[bj][1]; }
            }
        }
    }
};

struct EpiOut {
    static constexpr bool PERM = false, AFTER_DRAIN = true;
    bf16_t* xb; float* ssqp; int bid;
    __device__ __forceinline__ void fused(f32x4 (&acc)[2][2][4][2], const Unit& u, int wr, int wc, int fr, int fq, PG8_LAS unsigned char* lds, int wid, int lane) const {
        PG8_LAS float* P = (PG8_LAS float*)lds;
        int row0 = wr * 64 + fr, col0 = u.pn * BM + wc * 32 + 4 * fq;
        asm volatile("" : "+v"(row0), "+v"(col0));
#pragma unroll
        for (int ai = 0; ai < 2; ++ai)
#pragma unroll
            for (int m = 0; m < 4; ++m) {
                const int rl = row0 + ai * HALF + m * 16; const size_t off = (size_t)(u.pm * BM + rl) * DM + col0;
                uint2 xo[2][2];
#pragma unroll
                for (int bj = 0; bj < 2; ++bj)
#pragma unroll
                    for (int n = 0; n < 2; ++n) xo[bj][n] = *(const uint2*)(xb + off + bj * HALF + n * 16);
                float ss = 0.f;
#pragma unroll
                for (int bj = 0; bj < 2; ++bj)
#pragma unroll
                    for (int n = 0; n < 2; ++n) {
                        const uint2 w0 = xo[bj][n];
                        f32x4 xn = acc[ai][bj][m][n];
                        xn[0] += __uint_as_float(w0.x << 16); xn[1] += __uint_as_float(w0.x & 0xffff0000u); xn[2] += __uint_as_float(w0.y << 16); xn[3] += __uint_as_float(w0.y & 0xffff0000u);
                        uint2 w; w.x = cvt_pk_bf16(xn[0], xn[1]); w.y = cvt_pk_bf16(xn[2], xn[3]);
                        *(uint2*)(xb + off + bj * HALF + n * 16) = w;
                        ss += (xn[0] * xn[0] + xn[1] * xn[1]) + (xn[2] * xn[2] + xn[3] * xn[3]);
                    }
                ss += __shfl_xor(ss, 16); ss += __shfl_xor(ss, 32);
                if (fq == 0) P[rl * 4 + wc] = ss;
            }
        asm volatile("s_waitcnt lgkmcnt(0)" ::: "memory"); __builtin_amdgcn_s_barrier(); asm volatile("" ::: "memory");
        const int t = wid * 64 + lane;
        if (t < 256) { const f32x4 p = *(const PG8_LAS f32x4*)(P + t * 4); ssqp[(size_t)(u.pm * BM + t) * 4 + u.pn] = (p[0] + p[1]) + (p[2] + p[3]); }
        asm volatile("s_waitcnt lgkmcnt(0)" ::: "memory"); __builtin_amdgcn_s_barrier(); asm volatile("" ::: "memory");
    }
};
template <class Epi, class Sched, bool YG>
__device__ __forceinline__ void gemm_phase(PG8_LAS unsigned char* lds, const Gemm g, const Sched& S, const Epi& E, int tid_in) {
    int tid_ = tid_in; asm volatile("" : "+v"(tid_));
    const int tid = tid_, wid = __builtin_amdgcn_readfirstlane(tid >> 6), lane = tid & 63, wr = wid >> 2, wc = wid & 3, fr = lane & 15, fq = lane >> 4;
    const int K = g.K, nt = K / BK;
    unsigned voffA[2], voffB[2];
#pragma unroll
    for (int i = 0; i < 2; ++i) { int R, C; stage_rc(tid * 16 + i * 8192, R, C); const int Rb = Epi::PERM ? ((R & ~31) + perm32(R & 31)) : R;
        voffA[i] = (unsigned)(R * g.lda + C) * 2u; voffB[i] = (unsigned)(Rb * K + C) * 2u; }
    const size_t kstep = (size_t)(BK * 2);
    const size_t hstep = (size_t)HALF * K * 2;
    const size_t tstep = 2 * hstep;
    const size_t hstepA = (size_t)HALF * g.lda * 2, tstepA = 2 * hstepA;
    const unsigned ldsw = (unsigned)wid * 1024u;
    const int aoff = lds_byte(wr * 64 + fr, fq * 8), boff = lds_byte(wc * 32 + fr, fq * 8);
#define PG8_SA(b, h) (((b) * 2 + (h)) * HTB)
#define PG8_SB(b, h) ((4 + (b) * 2 + (h)) * HTB)
#define PG8_STAGE(bufoff, gbase, voff) do { _Pragma("unroll") for (int _i = 0; _i < 2; ++_i) \
        __builtin_amdgcn_global_load_lds((const unsigned*)((const char*)(gbase) + (voff)[_i]), (PG8_LAS unsigned*)(lds + (bufoff) + ldsw + _i * 8192), 16, 0, 0); } while (0)
#define PG8_LDA(dst, b, h) do { _Pragma("unroll") for (int m = 0; m < 4; ++m) _Pragma("unroll") for (int k = 0; k < 2; ++k) dst[m][k] = *(const PG8_LAS bf16x8*)(lds + PG8_SA(b, h) + aoff + m * 2048 + k * 1024); } while (0)
#define PG8_LDB(dst, b, h) do { _Pragma("unroll") for (int n = 0; n < 2; ++n) _Pragma("unroll") for (int k = 0; k < 2; ++k) dst[n][k] = *(const PG8_LAS bf16x8*)(lds + PG8_SB(b, h) + boff + n * 2048 + k * 1024); } while (0)
#define PG8_MMA(ai, bj, At, Bt) do { __builtin_amdgcn_s_setprio(1); _Pragma("unroll") for (int m = 0; m < 4; ++m) _Pragma("unroll") for (int n = 0; n < 2; ++n) _Pragma("unroll") for (int k = 0; k < 2; ++k) \
        acc[ai][bj][m][n] = __builtin_amdgcn_mfma_f32_16x16x32_bf16(Bt[n][k], At[m][k], acc[ai][bj][m][n], 0, 0, 0); __builtin_amdgcn_s_setprio(0); } while (0)
#define PG8_WAIT_V(n) asm volatile("s_waitcnt vmcnt(" #n ")" ::: "memory")
#define PG8_WAIT_L(n) asm volatile("s_waitcnt lgkmcnt(" #n ")" ::: "memory")
#define PG8_BAR __builtin_amdgcn_s_barrier()
#define PG8_SCHED __builtin_amdgcn_sched_barrier(0)
    Unit cur, nxt; int ui = 0;
    if (!S.next(0, cur)) return;
    f32x4 acc[2][2][4][2];
#pragma unroll
    for (int a = 0; a < 2; ++a)
#pragma unroll
        for (int b = 0; b < 2; ++b)
#pragma unroll
            for (int m = 0; m < 4; ++m)
#pragma unroll
                for (int n = 0; n < 2; ++n) acc[a][b][m][n] = (f32x4){0.f, 0.f, 0.f, 0.f};
    bf16x8 At[4][2], B0[2][2], B1[2][2];
    const char* cA = (const char*)g.A + (size_t)cur.pm * tstepA; const char* cB = (const char*)g.Bt + (size_t)cur.pn * tstep;
    S.a_ready(cur);
    PG8_STAGE(PG8_SB(0, 0), cB, voffB); PG8_STAGE(PG8_SA(0, 0), cA + koffA<YG>(0), voffA); PG8_STAGE(PG8_SB(0, 1), cB + hstep, voffB); PG8_STAGE(PG8_SA(0, 1), cA + koffA<YG>(0) + hstepA, voffA);
    if (wr == 1) PG8_BAR;
    PG8_WAIT_V(4); PG8_BAR;
    PG8_STAGE(PG8_SB(1, 0), cB + kstep, voffB); PG8_STAGE(PG8_SA(1, 0), cA + koffA<YG>(1), voffA); PG8_STAGE(PG8_SB(1, 1), cB + hstep + kstep, voffB);
    PG8_WAIT_V(6); PG8_BAR;
    for (;;) {
        const bool has_next = S.next(ui + 1, nxt);
        const char* nA = has_next ? (const char*)g.A + (size_t)nxt.pm * tstepA : cA; const char* nB = has_next ? (const char*)g.Bt + (size_t)nxt.pn * tstep : cB;
        PSUB_T0(E, 42);
        for (int t = 0; t < nt; t += 2) {
            const bool last = (t == nt - 2);
            const char* a1 = cA + koffA<YG>(t + 1);
            const char* a2 = last ? nA + koffA<YG>(0) : cA + koffA<YG>(t + 2); const char* b2 = last ? nB : cB + (size_t)(t + 2) * kstep;
            const char* a3 = last ? nA + koffA<YG>(1) : cA + koffA<YG>(t + 3); const char* b3 = b2 + kstep;
            if (last && has_next) S.a_ready(nxt);
            PG8_LDB(B0, 0, 0); PG8_SCHED; PG8_LDA(At, 0, 0); PG8_STAGE(PG8_SA(1, 1), a1 + hstepA, voffA);
            PG8_WAIT_L(8); PG8_BAR; PG8_WAIT_L(0); PG8_MMA(0, 0, At, B0); PG8_BAR; PG8_SCHED;
            PG8_LDB(B1, 0, 1); PG8_STAGE(PG8_SB(0, 0), b2, voffB);
            PG8_BAR; PG8_WAIT_L(0); PG8_MMA(0, 1, At, B1); PG8_BAR;
            PG8_LDA(At, 0, 1); PG8_STAGE(PG8_SA(0, 0), a2, voffA);
            PG8_BAR; PG8_WAIT_L(0); PG8_MMA(1, 0, At, B0); PG8_BAR; PG8_SCHED;
            PG8_STAGE(PG8_SB(0, 1), b2 + hstep, voffB);
            PG8_WAIT_V(6); PG8_BAR; PG8_MMA(1, 1, At, B1); PG8_BAR;
            PG8_LDB(B0, 1, 0); PG8_SCHED; PG8_LDA(At, 1, 0); PG8_STAGE(PG8_SA(0, 1), a2 + hstepA, voffA);
            PG8_WAIT_L(8); PG8_BAR; PG8_WAIT_L(0); PG8_MMA(0, 0, At, B0); PG8_BAR; PG8_SCHED;
            PG8_LDB(B1, 1, 1); PG8_STAGE(PG8_SB(1, 0), b3, voffB);
            PG8_BAR; PG8_WAIT_L(0); PG8_MMA(0, 1, At, B1); PG8_BAR;
            PG8_LDA(At, 1, 1); PG8_STAGE(PG8_SA(1, 0), a3, voffA);
            PG8_BAR; PG8_WAIT_L(0); PG8_MMA(1, 0, At, B0); PG8_BAR; PG8_SCHED;
            PG8_STAGE(PG8_SB(1, 1), b3 + hstep, voffB);
            PG8_WAIT_V(6); PG8_BAR; PG8_MMA(1, 1, At, B1); PG8_BAR;
        }
        PSUB_T1(E, 42);
        if constexpr (!Epi::AFTER_DRAIN) { PSUB_T0(E, 40); E(acc, cur, wr, wc, fr, fq); S.done(cur); PSUB_T1(E, 40); }
        if (!has_next) break;
#pragma unroll
        for (int a = 0; a < 2; ++a)
#pragma unroll
            for (int b = 0; b < 2; ++b)
#pragma unroll
                for (int m = 0; m < 4; ++m)
#pragma unroll
                    for (int n = 0; n < 2; ++n) acc[a][b][m][n] = (f32x4){0.f, 0.f, 0.f, 0.f};
        cur = nxt; cA = nA; cB = nB; ++ui;
    }
    PG8_WAIT_V(0);
    if (wr == 0) PG8_BAR;
    PG8_BAR;
    if constexpr (Epi::AFTER_DRAIN) { E.fused(acc, cur, wr, wc, fr, fq, lds, wid, lane); S.done(cur); }
#undef PG8_SA
#undef PG8_SB
#undef PG8_STAGE
#undef PG8_LDA
#undef PG8_LDB
#undef PG8_MMA
#undef PG8_WAIT_V
#undef PG8_WAIT_L
#undef PG8_BAR
#undef PG8_SCHED
}

}

#define NTHREADS 512
#define LDS_BYTES 147456

struct Args {
    const float *x, *norm_w, *w_in, *conv_w, *conv_b, *gate_bias, *ret_nw, *ml_nw, *w_out, *final_nw;
    float* out; unsigned char* ws; int ph_lo, ph_hi;
};

struct Ctx {
    LAS unsigned char* lds;
    int tid, lane, wave, G, bid;
};

#define GT 256
#define LDS_GRP_SCR(g) (LDS_CTL_OFF + 1024 + (g) * 6144)
#define LDS_PRE (LDS_CTL_OFF + 1024 + 2 * 6144)
struct GCtx {
    LAS unsigned char* lds;
    LAS unsigned char* scr;
    volatile LAS unsigned* bctr;
    unsigned gen;
    int tid, lane, wave, grp;
    int gg, ng, bid;
};
__device__ __forceinline__ void gsync(GCtx& c) {
    asm volatile("s_waitcnt lgkmcnt(0)" ::: "memory");
    if (c.lane == 0) __hip_atomic_fetch_add((LAS unsigned*)c.bctr, 1u, __ATOMIC_RELAXED, __HIP_MEMORY_SCOPE_WORKGROUP);
    c.gen += 4u;
    while ((unsigned)__builtin_amdgcn_readfirstlane((int)__hip_atomic_load((LAS unsigned*)c.bctr, __ATOMIC_RELAXED, __HIP_MEMORY_SCOPE_WORKGROUP)) < c.gen) __builtin_amdgcn_s_sleep(0);
    asm volatile("" ::: "memory");
}
#define UNIT_FENCE(g) do { asm volatile("" : "+v"((g).tid)); (g).lane = (g).tid & 63; } while (0)
__device__ __forceinline__ GCtx make_group(const Ctx& c) {
    GCtx g; g.grp = c.wave >> 2; g.wave = c.wave & 3; g.tid = c.tid & 255; g.lane = c.lane;
    g.lds = c.lds + g.grp * 65536; g.scr = c.lds + LDS_GRP_SCR(g.grp);
    g.bctr = (volatile LAS unsigned*)(c.lds + LDS_CTL_OFF + 96) + g.grp;
    g.gen = *g.bctr;
    g.gg = c.bid * 2 + g.grp; g.ng = c.G * 2; g.bid = c.bid;
    __syncthreads();
    return g;
}

__device__ __forceinline__ void transpose_item(const float* W, int K, int Nsrc, int nblk, bf16_t* WT, const float* sc, LAS float* scr, int item, int lane) {
    const int kb = item / nblk, nb = item % nblk, k0 = 64 * kb, n0 = 32 * nb;
    {
        f32x4 v[8]; float s8[8];
#pragma unroll
        for (int i = 0; i < 8; ++i) { const int kk = 8 * i + (lane >> 3); v[i] = *(const f32x4*)(W + (size_t)(k0 + kk) * Nsrc + n0 + 4 * (lane & 7)); s8[i] = sc ? sc[k0 + kk] : 1.f; }
#pragma unroll
        for (int i = 0; i < 8; ++i) { const int kk = 8 * i + (lane >> 3); LAS float* d = scr + kk * 33 + 4 * (lane & 7);
            d[0] = v[i][0] * s8[i]; d[1] = v[i][1] * s8[i]; d[2] = v[i][2] * s8[i]; d[3] = v[i][3] * s8[i]; }
    }
    LDS_WAIT(); asm volatile("" ::: "memory");
    const int c = lane & 7;
#pragma unroll
    for (int j = 0; j < 4; ++j) { const int n = (lane >> 3) + 8 * j; const LAS float* s = scr + (8 * c) * 33 + n;
        u32x4 o; o.x = pk2(s[0 * 33], s[1 * 33]); o.y = pk2(s[2 * 33], s[3 * 33]); o.z = pk2(s[4 * 33], s[5 * 33]); o.w = pk2(s[6 * 33], s[7 * 33]);
        *(u32x4*)(WT + (size_t)(n0 + n) * K + k0 + 8 * c) = o; }
    LDS_WAIT(); asm volatile("" ::: "memory");
}

__device__ __forceinline__ void convert_w_in(const Ctx& c, const Args& a, int l) {
    LAS float* scr = (LAS float*)(c.lds + c.wave * 16384);
    const int gw = c.bid * 8 + c.wave, NGW = c.G * 8;
    const float* W = a.w_in + (size_t)l * DM * NIN; const float* nw = a.norm_w + (size_t)l * DM;
    bf16_t* WT = (bf16_t*)(a.ws + WS_WTIN);
    constexpr int NBLK = NP / 32, NITEMS = (DM / 64) * NBLK;
    for (int it = gw; it < NITEMS; it += NGW) transpose_item(W, DM, NIN, NBLK, WT, nw, scr, it, c.lane);
    bf16_t* WG = (bf16_t*)(a.ws + WS_WG);
    for (int i = c.bid * NTHREADS + c.tid; i < 8 * DM; i += c.G * NTHREADS) { const int j = i >> 10, k = i & 1023; WG[i] = f2bf(W[(size_t)k * NIN + NP + j] * nw[k]); }
}
__device__ __forceinline__ void convert_w_out(const Ctx& c, const Args& a, int l, int rot = 0) {
    LAS float* scr = (LAS float*)(c.lds + c.wave * 16384);
    const int NGW = c.G * 8, gw = (c.bid * 8 + c.wave + rot) % NGW;
    const float* W = a.w_out + (size_t)l * MIXW * DM;
    bf16_t* WT = (bf16_t*)(a.ws + WS_WTOUT);
    constexpr int NBLK = DM / 32, NITEMS = (MIXW / 64) * NBLK;
    for (int it = gw; it < NITEMS; it += NGW) transpose_item(W, MIXW, DM, NBLK, WT, nullptr, scr, it, c.lane);
}

__device__ __forceinline__ void rope_entry(float2* tab, int i) {
    int pos = i >> 5, f = i & 31;
    double a = (double)pos * c_theta[f];
    double k = rint(a * 0.63661977236758134308);
    double r = a - k * 1.57079632679489661923;
    r -= k * 6.123233995736766e-17;
    double r2 = r * r;
    double s = r * (1.0 + r2 * (-1.0 / 6 + r2 * (1.0 / 120 + r2 * (-1.0 / 5040 + r2 * (1.0 / 362880 + r2 * (-1.0 / 39916800 + r2 * (1.0 / 6227020800.0)))))));
    double cc = 1.0 + r2 * (-0.5 + r2 * (1.0 / 24 + r2 * (-1.0 / 720 + r2 * (1.0 / 40320 + r2 * (-1.0 / 3628800 + r2 * (1.0 / 479001600.0 + r2 * (-1.0 / 87178291200.0)))))));
    long long kq = (long long)k; int q = (int)(kq & 3);
    double cs, sn;
    if (q == 0) { cs = cc; sn = s; } else if (q == 1) { cs = -s; sn = cc; } else if (q == 2) { cs = -cc; sn = -s; } else { cs = s; sn = -cc; }
    tab[i] = make_float2((float)cs, (float)sn);
}

__device__ __forceinline__ void xprep_row(const float* xrow, float* orow, bf16_t* brow, float* ssq4, int lane) {
    const f32x4* xr = (const f32x4*)xrow + lane;
    f32x4 v[4]; float s = 0.f;
#pragma unroll
    for (int j = 0; j < 4; ++j) { v[j] = xr[64 * j]; s += (v[j][0] * v[j][0] + v[j][1] * v[j][1]) + (v[j][2] * v[j][2] + v[j][3] * v[j][3]); }
#pragma unroll
    for (int o = 1; o < 64; o <<= 1) s += __shfl_xor(s, o);
    if (orow) {
#pragma unroll
        for (int j = 0; j < 4; ++j) ((f32x4*)orow + lane)[64 * j] = v[j];
    }
    unsigned long long* o8 = (unsigned long long*)brow + lane;
#pragma unroll
    for (int j = 0; j < 4; ++j) o8[64 * j] = (unsigned long long)pk2(v[j][0], v[j][1]) | ((unsigned long long)pk2(v[j][2], v[j][3]) << 32);
    if (lane == 0) *(f32x4*)ssq4 = (f32x4){s, 0.f, 0.f, 0.f};
}

__device__ __forceinline__ void phase_p0(const Ctx& c, const Args& a) {
    convert_w_in(c, a, 0);
    convert_w_out(c, a, 0, c.G * 8 - 128);
    float2* rope = (float2*)(a.ws + WS_ROPE);
    for (int i = c.bid * NTHREADS + c.tid; i < SEQ * 32; i += c.G * NTHREADS) rope_entry(rope, i);
    const int gw = c.bid * 8 + c.wave, NGW = c.G * 8;
    bf16_t* xb = (bf16_t*)(a.ws + WS_XB); float* ssqp = (float*)(a.ws + WS_SSQP);
    for (int m = gw; m < SEQ; m += 2 * NGW) {
        f32x4 v[2][4]; float s[2];
#pragma unroll
        for (int r = 0; r < 2; ++r) { const f32x4* xr = (const f32x4*)(a.x + (size_t)(m + r * NGW) * DM) + c.lane;
#pragma unroll
            for (int j = 0; j < 4; ++j) v[r][j] = xr[64 * j]; }
#pragma unroll
        for (int r = 0; r < 2; ++r) { float q = 0.f;
#pragma unroll
            for (int j = 0; j < 4; ++j) q += (v[r][j][0] * v[r][j][0] + v[r][j][1] * v[r][j][1]) + (v[r][j][2] * v[r][j][2] + v[r][j][3] * v[r][j][3]);
#pragma unroll
            for (int o = 1; o < 64; o <<= 1) q += __shfl_xor(q, o);
            s[r] = q; }
#pragma unroll
        for (int r = 0; r < 2; ++r) { const int row = m + r * NGW;
            unsigned long long* o8 = (unsigned long long*)(xb + (size_t)row * DM) + c.lane;
#pragma unroll
            for (int j = 0; j < 4; ++j) o8[64 * j] = (unsigned long long)pk2(v[r][j][0], v[r][j][1]) | ((unsigned long long)pk2(v[r][j][2], v[r][j][3]) << 32);
            if (c.lane == 0) *(f32x4*)(ssqp + (size_t)row * 4) = (f32x4){s[r], 0.f, 0.f, 0.f}; }
    }
}

__device__ __forceinline__ void gates_rows(const Ctx& c, const Args& a) {
    const bf16_t* xb = (const bf16_t*)(a.ws + WS_XB); const bf16_t* WG = (const bf16_t*)(a.ws + WS_WG);
    const float* ssqp = (const float*)(a.ws + WS_SSQP); float* gates = (float*)(a.ws + WS_GATES);
    LAS f32x4* red = (LAS f32x4*)c.lds;
    const int i = c.lane & 15, g = c.lane >> 4, rt = c.wave & 3, kh = c.wave >> 2;
    for (int rb = c.bid; rb < SEQ / 64; rb += c.G) {
        const bf16_t* ap = xb + (size_t)(rb * 64 + rt * 16 + i) * DM + kh * 512 + 8 * g;
        const bf16_t* bp = WG + (size_t)(i & 7) * DM + kh * 512 + 8 * g;
        f32x4 acc = (f32x4){0.f, 0.f, 0.f, 0.f};
        f32x4 sq[4];
#pragma unroll
        for (int r = 0; r < 4; ++r) sq[r] = *(const f32x4*)(ssqp + (size_t)(rb * 64 + rt * 16 + 4 * g + r) * 4);
        {
            bf16x8 af[16], bf[16];
#pragma unroll
            for (int s = 0; s < 16; ++s) { af[s] = *(const bf16x8*)(ap + s * 32); bf[s] = *(const bf16x8*)(bp + s * 32); }
#pragma unroll
            for (int s = 0; s < 16; ++s) { const bf16x8 b = i < 8 ? bf[s] : (bf16x8){0, 0, 0, 0, 0, 0, 0, 0}; acc = __builtin_amdgcn_mfma_f32_16x16x32_bf16(af[s], b, acc, 0, 0, 0); }
        }
        if (kh == 1) red[rt * 64 + c.lane] = acc;
        __syncthreads();
        if (kh == 0) {
            acc += red[rt * 64 + c.lane];
            if (i < 8) {
#pragma unroll
                for (int r = 0; r < 4; ++r) {
                    const int row = rb * 64 + rt * 16 + 4 * g + r;
                    const f32x4 s4 = sq[r];
                    const float rs = rsqrtf(((s4[0] + s4[1]) + (s4[2] + s4[3])) * (1.0f / 1024.0f) + 1e-6f);
                    gates[(size_t)row * 8 + i] = acc[r] * rs;
                }
            }
        }
        __syncthreads();
    }
}

__device__ __forceinline__ void phase_pa(const Ctx& c, const Args& a) {
    PSUB_T0(c, 43);
    PSUB_T0(c, 41); gates_rows(c, a); PSUB_T1(c, 41);
    pg8::Gemm g{(const bf16_t*)(a.ws + WS_XB), (const bf16_t*)(a.ws + WS_WTIN), SEQ, 4096, DM, DM};
    pg8::StaticOrder S; S.init(SEQ, 4096, c.G, c.bid);
    pg8::EpiProj E{(bf16_t*)(a.ws + WS_PROJ), (const float*)(a.ws + WS_SSQP), (float*)(a.ws + WS_KMP), c.bid};
    pg8::gemm_phase<pg8::EpiProj, pg8::StaticOrder, false>(c.lds, g, S, E, c.tid);
    PSUB_T1(c, 43);
}

struct TailOrder {
    int pm;
    __device__ __forceinline__ bool next(int i, pg8::Unit& u) const { if (i > 0) return false; u.pm = pm; u.pn = 16; return true; }
    __device__ __forceinline__ void a_ready(const pg8::Unit&) const {}
    __device__ __forceinline__ void done(const pg8::Unit&) const {}
};
#define N_TAIL_WG 64
__device__ __forceinline__ void gemm_tail(const Ctx& c, const Args& a) {
    pg8::Gemm g{(const bf16_t*)(a.ws + WS_XB), (const bf16_t*)(a.ws + WS_WTIN), SEQ, NP, DM, DM};
    TailOrder S; S.pm = c.bid;
    pg8::EpiProj E{(bf16_t*)(a.ws + WS_PROJ), (const float*)(a.ws + WS_SSQP), (float*)(a.ws + WS_KMP), c.bid};
    pg8::gemm_phase<pg8::EpiProj, TailOrder, false>(c.lds, g, S, E, c.tid);
}
__device__ __forceinline__ void phase_pe(const Ctx& c, const Args& a) {
    pg8::Gemm g{(const bf16_t*)(a.ws + WS_PROJ), (const bf16_t*)(a.ws + WS_WTOUT), SEQ, DM, MIXW, NP};
    pg8::StaticOrder S; S.init(SEQ, DM, c.G, c.bid);
    pg8::EpiOut E{(bf16_t*)(a.ws + WS_XB), (float*)(a.ws + WS_SSQP), c.bid};
    pg8::gemm_phase<pg8::EpiOut, pg8::StaticOrder, true>(c.lds, g, S, E, c.tid);
}
__device__ __forceinline__ void phase_final(const Ctx& c, const Args& a) {
    const int gw = c.bid * 8 + c.wave, NGW = c.G * 8;
    const float* ssqp = (const float*)(a.ws + WS_SSQP); const bf16_t* xb = (const bf16_t*)(a.ws + WS_XB);
    f32x4 w[4];
#pragma unroll
    for (int j = 0; j < 4; ++j) w[j] = ((const f32x4*)a.final_nw + c.lane)[64 * j];
    for (int m = gw; m < SEQ; m += 2 * NGW) {
        uint2 xv[2][4]; f32x4 s4[2];
#pragma unroll
        for (int r = 0; r < 2; ++r) { const int row = m + r * NGW; s4[r] = *(const f32x4*)(ssqp + (size_t)row * 4);
#pragma unroll
            for (int j = 0; j < 4; ++j) xv[r][j] = ((const uint2*)(xb + (size_t)row * DM) + c.lane)[64 * j]; }
#pragma unroll
        for (int r = 0; r < 2; ++r) { const int row = m + r * NGW;
            const float rs = rsqrtf(((s4[r][0] + s4[r][1]) + (s4[r][2] + s4[r][3])) * (1.0f / 1024.0f) + 1e-6f);
            f32x4* xr = (f32x4*)(a.out + (size_t)row * DM) + c.lane;
#pragma unroll
            for (int j = 0; j < 4; ++j) { const uint2 q = xv[r][j];
                f32x4 v; v[0] = __uint_as_float(q.x << 16); v[1] = __uint_as_float(q.x & 0xffff0000u); v[2] = __uint_as_float(q.y << 16); v[3] = __uint_as_float(q.y & 0xffff0000u);
                xr[64 * j] = v * rs * w[j]; } }
    }
}

#define WS_RPREV  WS_END0
#define WS_CPREV  (WS_RPREV + 4ull * 64 * 4096 * 2)
#define WS_NPREV  (WS_CPREV + 4ull * 128 * 4096 * 2)
#define WS_MPREV  (WS_NPREV + 4ull * 128 * 64 * 4)
#define WS_PART   (WS_MPREV + 4096ull)
#define WS_PML    (WS_PART + (size_t)SEQ * 8 * 3 * 64 * 2)
#define WS_END1   (WS_PML + (size_t)SEQ * 8 * 3 * 8)
#define LIST_PER_HEAD 516096
#define WS_LIST   WS_END1
#define WS_KVRET  (WS_LIST + 8ull * LIST_PER_HEAD * 4)
#define WS_KVML   (WS_KVRET + 4ull * 64 * 4096 * 4)
#define WS_NLOC   (WS_KVML + 4ull * 128 * 4096 * 4)
#define WS_MLOC   (WS_NLOC + 4ull * 128 * 64 * 4)
#define WS_BC     (WS_MLOC + 4ull * 128 * 4)
#define WS_END2   (WS_BC + 4ull * 128 * 4)

typedef short s16x4 __attribute__((ext_vector_type(4)));
#define TILE_OFF(row, c16) ((row) * 128 + (((((c16) >> 1) ^ (((row) >> 1) & 3))) << 5) + (((c16) & 1) << 4))
#define MFMA16(a, b, c) __builtin_amdgcn_mfma_f32_16x16x32_bf16(a, b, c, 0, 0, 0)
#define LDS_KT 0
#define LDS_VT 32768

__device__ __forceinline__ void unpack8(const u32x4 x, float (&v)[8]) {
    v[0] = __uint_as_float(x.x << 16); v[1] = __uint_as_float(x.x & 0xffff0000u); v[2] = __uint_as_float(x.y << 16); v[3] = __uint_as_float(x.y & 0xffff0000u);
    v[4] = __uint_as_float(x.z << 16); v[5] = __uint_as_float(x.z & 0xffff0000u); v[6] = __uint_as_float(x.w << 16); v[7] = __uint_as_float(x.w & 0xffff0000u);
}
__device__ __forceinline__ u32x4 pack8(const float (&v)[8]) { u32x4 w; w.x = pk2(v[0], v[1]); w.y = pk2(v[2], v[3]); w.z = pk2(v[4], v[5]); w.w = pk2(v[6], v[7]); return w; }
__device__ __forceinline__ void tile_store8(LAS unsigned char* tile, int row, int c16, const float (&v)[8]) { *(LAS u32x4*)(tile + TILE_OFF(row, c16)) = pack8(v); }
__device__ __forceinline__ bf16x8 tile_rowfrag(LAS unsigned char* tile, int row, int c16) { return *(const LAS bf16x8*)(tile + TILE_OFF(row, c16)); }
typedef short v4i16_t __attribute__((ext_vector_type(4)));
__device__ __forceinline__ s16x4 lds_tr(LAS unsigned char* p) { return __builtin_bit_cast(s16x4, __builtin_amdgcn_ds_read_tr16_b64_v4i16((LAS v4i16_t*)p)); }
__device__ __forceinline__ bf16x8 tile_trfrag(LAS unsigned char* tile, int key0, int et, int lane) {
    const int i = lane & 15, g = lane >> 4, r1 = key0 + 4 * g + (i >> 2);
    LAS unsigned char* p = tile + r1 * 128 + ((et ^ ((r1 >> 1) & 3)) << 5) + (i & 3) * 8;
    const s16x4 a = lds_tr(p), b = lds_tr(p + 2048);
    return (bf16x8){a[0], a[1], a[2], a[3], b[0], b[1], b[2], b[3]};
}
__device__ __forceinline__ f32x4 st_tile(LAS unsigned char* Kt, int krow0, const bf16x8 (&qf)[2], int lane) {
    const int key = krow0 + (lane & 15), g = lane >> 4;
    f32x4 acc = (f32x4){0.f, 0.f, 0.f, 0.f};
    acc = MFMA16(tile_rowfrag(Kt, key, g), qf[0], acc);
    acc = MFMA16(tile_rowfrag(Kt, key, 4 + g), qf[1], acc);
    return acc;
}
__device__ __forceinline__ void pv_step(LAS unsigned char* Vt, int key0, const f32x4& s0, const f32x4& s1, f32x4 (&O)[4], int lane) {
    u32x4 pw; pw.x = pg8::cvt_pk_bf16(s0[0], s0[1]); pw.y = pg8::cvt_pk_bf16(s0[2], s0[3]); pw.z = pg8::cvt_pk_bf16(s1[0], s1[1]); pw.w = pg8::cvt_pk_bf16(s1[2], s1[3]);
    const bf16x8 pf = __builtin_bit_cast(bf16x8, pw);
#pragma unroll
    for (int et = 0; et < 4; ++et) O[et] = MFMA16(tile_trfrag(Vt, key0, et, lane), pf, O[et]);
}
__device__ __forceinline__ void st_pairs(LAS unsigned char* Kt, const bf16x8 (&qf)[2], int np, f32x4 (&S)[16], int lane) {
    const int i = lane & 15, g = lane >> 4;
    bf16x8 kf[2][2][2];
    kf[0][0][0] = tile_rowfrag(Kt, i, g); kf[0][0][1] = tile_rowfrag(Kt, i, 4 + g); kf[0][1][0] = tile_rowfrag(Kt, 16 + i, g); kf[0][1][1] = tile_rowfrag(Kt, 16 + i, 4 + g);
#pragma unroll
    for (int p = 0; p < 8; ++p) {
        if (p < np) {
            if (p + 1 < np) { const int r = 32 * (p + 1) + i;
                kf[(p + 1) & 1][0][0] = tile_rowfrag(Kt, r, g); kf[(p + 1) & 1][0][1] = tile_rowfrag(Kt, r, 4 + g); kf[(p + 1) & 1][1][0] = tile_rowfrag(Kt, r + 16, g); kf[(p + 1) & 1][1][1] = tile_rowfrag(Kt, r + 16, 4 + g); }
            __builtin_amdgcn_sched_barrier(0);
            f32x4 a0 = (f32x4){0.f, 0.f, 0.f, 0.f}, a1 = a0;
            a0 = MFMA16(kf[p & 1][0][0], qf[0], a0); a1 = MFMA16(kf[p & 1][1][0], qf[0], a1);
            a0 = MFMA16(kf[p & 1][0][1], qf[1], a0); a1 = MFMA16(kf[p & 1][1][1], qf[1], a1);
            S[2 * p] = a0; S[2 * p + 1] = a1;
            __builtin_amdgcn_sched_barrier(0);
        }
    }
}
__device__ __forceinline__ void trfrag4(LAS unsigned char* Vt, int key0, bf16x8 (&vf)[4], int lane) {
#pragma unroll
    for (int et = 0; et < 4; ++et) vf[et] = tile_trfrag(Vt, key0, et, lane);
}
__device__ __forceinline__ float grp4_sum(float v) { v += __shfl_xor(v, 16); v += __shfl_xor(v, 32); return v; }
__device__ __forceinline__ float grp4_max(float v) { v = fmaxf(v, __shfl_xor(v, 16)); v = fmaxf(v, __shfl_xor(v, 32)); return v; }

__device__ __forceinline__ void headnorm_store_pre(f32x4 (&O)[4], const f32x4 (&nw4)[4], const uint2 (&gt)[4], bf16_t* grow, int lane) {
    const int g = lane >> 4;
    float s = 0.f;
#pragma unroll
    for (int et = 0; et < 4; ++et) s += (O[et][0] + O[et][1]) + (O[et][2] + O[et][3]);
    const float mu = grp4_sum(s) * (1.f / 64.f);
    float q = 0.f;
#pragma unroll
    for (int et = 0; et < 4; ++et)
#pragma unroll
        for (int r = 0; r < 4; ++r) { const float d = O[et][r] - mu; q += d * d; }
    const float rstd = rsqrtf(grp4_sum(q) * (1.f / 64.f) + 1e-5f);
#pragma unroll
    for (int et = 0; et < 4; ++et) {
        const uint2 gw = gt[et]; const f32x4 w4 = nw4[et];
        const float g0 = __uint_as_float(gw.x << 16), g1 = __uint_as_float(gw.x & 0xffff0000u), g2 = __uint_as_float(gw.y << 16), g3 = __uint_as_float(gw.y & 0xffff0000u);
        uint2 o;
        o.x = pk2((O[et][0] - mu) * rstd * w4[0] * siluf(g0), (O[et][1] - mu) * rstd * w4[1] * siluf(g1));
        o.y = pk2((O[et][2] - mu) * rstd * w4[2] * siluf(g2), (O[et][3] - mu) * rstd * w4[3] * siluf(g3));
        *(uint2*)(grow + et * 16 + 4 * g) = o;
    }
}
__device__ __forceinline__ int tile16_of(int wave, int k) { return k == 0 ? 15 - wave : (k == 1 ? wave : (k == 2 ? 8 + wave : 7 - wave)); }

template <int NTOK>
__device__ __forceinline__ void kvt_mfma(const GCtx& c, float* out) {
    LAS unsigned char* Kt = c.lds + LDS_KT; LAS unsigned char* Vt = c.lds + LDS_VT;
    const int et = c.wave, i = c.lane & 15, g = c.lane >> 4;
    f32x4 acc[4];
#pragma unroll
    for (int dt = 0; dt < 4; ++dt) acc[dt] = (f32x4){0.f, 0.f, 0.f, 0.f};
#pragma unroll
    for (int s = 0; s < NTOK / 32; ++s) {
        const bf16x8 af = tile_trfrag(Vt, 32 * s, et, c.lane);
#pragma unroll
        for (int dt = 0; dt < 4; ++dt) acc[dt] = MFMA16(af, tile_trfrag(Kt, 32 * s, dt, c.lane), acc[dt]);
    }
#pragma unroll
    for (int dt = 0; dt < 4; ++dt)
#pragma unroll
        for (int r = 0; r < 4; ++r) out[(et * 16 + 4 * g + r) * 64 + dt * 16 + i] = acc[dt][r];
}

template <bool ZETA>
__device__ __forceinline__ void ret_stage(const GCtx& c, const Args& a, int h, int T0, float lg2g) {
    const bf16_t* proj = (const bf16_t*)(a.ws + WS_PROJ); const float2* rope = (const float2*)(a.ws + WS_ROPE);
    LAS unsigned char* Kt = c.lds + LDS_KT; LAS unsigned char* Vt = c.lds + LDS_VT;
#pragma unroll
    for (int half = 0; half < 2; ++half) {
        u32x4 klo[2], khi[2], vv[4]; f32x4 rr[2][4];
#pragma unroll
        for (int q = 0; q < 2; ++q) { const int it = c.tid + (2 * half + q) * GT, row = it >> 2, cq = it & 3; const size_t t = (size_t)(T0 + row);
            klo[q] = *(const u32x4*)(proj + t * NP + C_BK + h * 64 + 8 * cq); khi[q] = *(const u32x4*)(proj + t * NP + C_BK + h * 64 + 32 + 8 * cq);
            const f32x4* rp = (const f32x4*)(rope + t * 32 + 8 * cq);
#pragma unroll
            for (int j = 0; j < 4; ++j) rr[q][j] = rp[j]; }
#pragma unroll
        for (int q = 0; q < 4; ++q) { const int it = c.tid + (4 * half + q) * GT, row = it >> 3, c16 = it & 7; vv[q] = *(const u32x4*)(proj + (size_t)(T0 + row) * NP + C_BV + h * 64 + 8 * c16); }
#pragma unroll
        for (int q = 0; q < 2; ++q) { const int it = c.tid + (2 * half + q) * GT, row = it >> 2, cq = it & 3;
            const float sc = ZETA ? 0.125f * exp2f(lg2g * (float)(255 - row)) : 0.125f;
            float lo[8], hi[8], olo[8], ohi[8]; unpack8(klo[q], lo); unpack8(khi[q], hi);
#pragma unroll
            for (int j2 = 0; j2 < 4; ++j2) { const f32x4 cs = rr[q][j2];
                olo[2 * j2] = (lo[2 * j2] * cs[0] - hi[2 * j2] * cs[1]) * sc; ohi[2 * j2] = (lo[2 * j2] * cs[1] + hi[2 * j2] * cs[0]) * sc;
                olo[2 * j2 + 1] = (lo[2 * j2 + 1] * cs[2] - hi[2 * j2 + 1] * cs[3]) * sc; ohi[2 * j2 + 1] = (lo[2 * j2 + 1] * cs[3] + hi[2 * j2 + 1] * cs[2]) * sc; }
            tile_store8(Kt, row, cq, olo); tile_store8(Kt, row, 4 + cq, ohi); }
#pragma unroll
        for (int q = 0; q < 4; ++q) { const int it = c.tid + (4 * half + q) * GT, row = it >> 3, c16 = it & 7; *(LAS u32x4*)(Vt + TILE_OFF(row, c16)) = vv[q]; }
    }
}
__device__ __forceinline__ void ret_x1_unit(GCtx& c, const Args& a, int h, int ch) {
    const float lg2g = log2f(1.f - exp2f(-5.f - (float)h));
    ret_stage<true>(c, a, h, ch * 256, lg2g);
    gsync(c);
    kvt_mfma<256>(c, (float*)(a.ws + WS_KVRET) + ((size_t)h * 64 + ch) * 4096);
    gsync(c);
}
struct RetPre { u32x4 qlo, qhi; f32x4 rp[4]; uint2 gt[4]; };
__device__ __forceinline__ void ret_prefetch(const GCtx& c, const Args& a, int h, int ch, int wt, RetPre& p) {
    const bf16_t* proj = (const bf16_t*)(a.ws + WS_PROJ); const float2* rope = (const float2*)(a.ws + WS_ROPE);
    const int i = c.lane & 15, g = c.lane >> 4, t = ch * 256 + wt * 16 + i;
    const bf16_t* qrow = proj + (size_t)t * NP + C_BQ + h * 64;
    p.qlo = *(const u32x4*)(qrow + 8 * g); p.qhi = *(const u32x4*)(qrow + 32 + 8 * g);
    const f32x4* rp = (const f32x4*)(rope + (size_t)t * 32 + 8 * g);
#pragma unroll
    for (int j = 0; j < 4; ++j) p.rp[j] = rp[j];
#pragma unroll
    for (int et = 0; et < 4; ++et) p.gt[et] = *(const uint2*)(proj + (size_t)t * NP + C_BG + h * 64 + et * 16 + 4 * g);
}
__device__ __forceinline__ void ret_compute(const GCtx& c, const Args& a, int h, int ch, int wt, float lg2g, const RetPre& p, const f32x4 (&nw4)[4]) {
    bf16_t* proj = (bf16_t*)(a.ws + WS_PROJ);
    LAS unsigned char* Kt = c.lds + LDS_KT; LAS unsigned char* Vt = c.lds + LDS_VT;
    const int i = c.lane & 15, g = c.lane >> 4, ql = wt * 16 + i, t = ch * 256 + ql;
    bf16x8 sf[4][2];
    { const bf16_t* St = (const bf16_t*)(a.ws + WS_RPREV) + ((size_t)h * 64 + ch) * 4096;
#pragma unroll
      for (int et = 0; et < 4; ++et) { const bf16_t* rp = St + (size_t)(et * 16 + i) * 64 + 8 * g; sf[et][0] = *(const bf16x8*)rp; sf[et][1] = *(const bf16x8*)(rp + 32); } }
    bf16x8 qf[2];
    {
        float lo[8], hi[8], olo[8], ohi[8];
        unpack8(p.qlo, lo); unpack8(p.qhi, hi);
#pragma unroll
        for (int j2 = 0; j2 < 4; ++j2) { const f32x4 cs = p.rp[j2];
            olo[2 * j2] = lo[2 * j2] * cs[0] - hi[2 * j2] * cs[1]; ohi[2 * j2] = lo[2 * j2] * cs[1] + hi[2 * j2] * cs[0];
            olo[2 * j2 + 1] = lo[2 * j2 + 1] * cs[2] - hi[2 * j2 + 1] * cs[3]; ohi[2 * j2 + 1] = lo[2 * j2 + 1] * cs[3] + hi[2 * j2 + 1] * cs[2]; }
        qf[0] = __builtin_bit_cast(bf16x8, pack8(olo)); qf[1] = __builtin_bit_cast(bf16x8, pack8(ohi));
    }
    const float F1 = exp2f(-lg2g), F2 = F1 * F1, F3 = F2 * F1, c16 = exp2f(-16.f * lg2g);
    float Ekt = exp2f(lg2g * (float)(ql - 4 * g));
    const bool m0 = (4 * g + 0) <= i, m1 = (4 * g + 1) <= i, m2 = (4 * g + 2) <= i, m3 = (4 * g + 3) <= i;
    const int np = (wt >> 1) + 1;
    f32x4 S[16];
    st_pairs(Kt, qf, np, S, c.lane);
    f32x4 O[4];
#pragma unroll
    for (int et = 0; et < 4; ++et) O[et] = (f32x4){0.f, 0.f, 0.f, 0.f};
    bf16x8 vf[2][4];
    trfrag4(Vt, 0, vf[0], c.lane);
#pragma unroll
    for (int s = 0; s < 8; ++s) {
        if (s < np) {
            if (s + 1 < np) trfrag4(Vt, 32 * (s + 1), vf[(s + 1) & 1], c.lane);
            __builtin_amdgcn_sched_barrier(0);
            u32x4 pw;
#pragma unroll
            for (int hh = 0; hh < 2; ++hh) { const int kt = 2 * s + hh;
                f32x4 v = S[kt];
                v[0] *= Ekt; v[1] *= Ekt * F1; v[2] *= Ekt * F2; v[3] *= Ekt * F3;
                if (kt == wt) { v[0] = m0 ? v[0] : 0.f; v[1] = m1 ? v[1] : 0.f; v[2] = m2 ? v[2] : 0.f; v[3] = m3 ? v[3] : 0.f; }
                if (kt > wt) v = (f32x4){0.f, 0.f, 0.f, 0.f};
                Ekt *= c16;
                if (hh == 0) { pw.x = pk2(v[0], v[1]); pw.y = pk2(v[2], v[3]); } else { pw.z = pk2(v[0], v[1]); pw.w = pk2(v[2], v[3]); } }
            const bf16x8 pf = __builtin_bit_cast(bf16x8, pw);
#pragma unroll
            for (int et = 0; et < 4; ++et) O[et] = MFMA16(vf[s & 1][et], pf, O[et]);
            __builtin_amdgcn_sched_barrier(0);
        }
    }
    const float xi = exp2f(lg2g * (float)(ql + 1));
#pragma unroll
    for (int et = 0; et < 4; ++et) {
        f32x4 x = (f32x4){0.f, 0.f, 0.f, 0.f};
        x = MFMA16(sf[et][0], qf[0], x); x = MFMA16(sf[et][1], qf[1], x);
        O[et] += x * xi;
    }
    headnorm_store_pre(O, nw4, p.gt, proj + (size_t)t * NP + C_BG + h * 64, c.lane);
}
__device__ __forceinline__ void ret_x3_unit(GCtx& c, const Args& a, int l, int h, int ch) {
    const float lg2g = log2f(1.f - exp2f(-5.f - (float)h));
    const int g = c.lane >> 4;
    RetPre cur; ret_prefetch(c, a, h, ch, tile16_of(c.wave, 0), cur);
    f32x4 nw4[4];
#pragma unroll
    for (int et = 0; et < 4; ++et) nw4[et] = *(const f32x4*)(a.ret_nw + (size_t)l * 256 + h * 64 + et * 16 + 4 * g);
    ret_stage<false>(c, a, h, ch * 256, lg2g);
    gsync(c);
#pragma unroll 1
    for (int k = 0; k < 4; ++k) {
        UNIT_FENCE(c);
        RetPre nxt; ret_prefetch(c, a, h, ch, tile16_of(c.wave, k < 3 ? k + 1 : 3), nxt);
        ret_compute(c, a, h, ch, tile16_of(c.wave, k), lg2g, cur, nw4);
        cur = nxt;
    }
    gsync(c);
}

__device__ __forceinline__ void conv8_raw(const u32x4 (&x)[4], const LAS float* cwl, const LAS float* cbl, int chl, int t, float (&out)[8]) {
    float acc[8];
    { const f32x4 b0 = *(const LAS f32x4*)(cbl + chl), b1 = *(const LAS f32x4*)(cbl + chl + 4);
      acc[0] = b0[0]; acc[1] = b0[1]; acc[2] = b0[2]; acc[3] = b0[3]; acc[4] = b1[0]; acc[5] = b1[1]; acc[6] = b1[2]; acc[7] = b1[3]; }
#pragma unroll
    for (int tap = 0; tap < 4; ++tap) {
        float xv[8]; unpack8(x[tap], xv);
        const float on = (t - 3 + tap) >= 0 ? 1.f : 0.f;
        const f32x4 w0 = *(const LAS f32x4*)(cwl + tap * 64 + chl) * on, w1 = *(const LAS f32x4*)(cwl + tap * 64 + chl + 4) * on;
        acc[0] = fmaf(w0[0], xv[0], acc[0]); acc[1] = fmaf(w0[1], xv[1], acc[1]); acc[2] = fmaf(w0[2], xv[2], acc[2]); acc[3] = fmaf(w0[3], xv[3], acc[3]);
        acc[4] = fmaf(w1[0], xv[4], acc[4]); acc[5] = fmaf(w1[1], xv[5], acc[5]); acc[6] = fmaf(w1[2], xv[6], acc[6]); acc[7] = fmaf(w1[3], xv[7], acc[7]);
    }
#pragma unroll
    for (int j = 0; j < 8; ++j) out[j] = siluf(acc[j]);
}
#define ML_CONV_OFF 896
__device__ __forceinline__ void ml_conv_to_lds(const GCtx& c, const Args& a, int l, int h) {
    const float* cw = a.conv_w + (size_t)l * 4 * 512; const float* cb = a.conv_b + (size_t)l * 512;
    LAS float* dst = (LAS float*)c.scr + ML_CONV_OFF;
    for (int i = c.tid; i < 640; i += GT) {
        const int seg = i >> 6, ch = h * 64 + (i & 63);
        dst[i] = seg < 4 ? cw[seg * 512 + ch] : (seg == 4 ? cb[ch] : (seg < 9 ? cw[(seg - 5) * 512 + 256 + ch] : cb[256 + ch]));
    }
}
__device__ __forceinline__ void load_taps(const bf16_t* proj, int col, int t, u32x4 (&x)[4]) {
#pragma unroll
    for (int tap = 0; tap < 4; ++tap) { const int tt = t - 3 + tap; x[tap] = *(const u32x4*)(proj + (size_t)(tt < 0 ? 0 : tt) * NP + col); }
}
__device__ __forceinline__ void ml_load_kv(const GCtx& c, const Args& a, int h, int T0, int half, u32x4 (&kx)[2][4], u32x4 (&vv)[2]) {
    const bf16_t* proj = (const bf16_t*)(a.ws + WS_PROJ);
#pragma unroll
    for (int q = 0; q < 2; ++q) { const int it = c.tid + (2 * half + q) * GT, row = it >> 3, c16 = it & 7;
        load_taps(proj, C_CK + h * 64 + 8 * c16, T0 + row, kx[q]); vv[q] = *(const u32x4*)(proj + (size_t)(T0 + row) * NP + C_CV + h * 64 + 8 * c16); }
}
__device__ __forceinline__ void ml_store_kv(const GCtx& c, const Args& a, int l, int h, int T0, int half, const u32x4 (&kx)[2][4], const u32x4 (&vv)[2], const LAS float* wrow) {
    const LAS float* cv = (const LAS float*)c.scr + ML_CONV_OFF;
    LAS unsigned char* Kt = c.lds + LDS_KT; LAS unsigned char* Vt = c.lds + LDS_VT;
#pragma unroll
    for (int q = 0; q < 2; ++q) { const int it = c.tid + (2 * half + q) * GT, row = it >> 3, c16 = it & 7;
        float k8[8]; conv8_raw(kx[q], cv + 320, cv + 576, 8 * c16, T0 + row, k8);
        const float sc = wrow ? 0.125f * wrow[row] : 0.125f;
#pragma unroll
        for (int j = 0; j < 8; ++j) k8[j] *= sc;
        tile_store8(Kt, row, c16, k8); *(LAS u32x4*)(Vt + TILE_OFF(row, c16)) = vv[q]; }
}
__device__ __forceinline__ float log_sigmoid(float f) { return fminf(f, 0.f) - 0.6931471805599453f * __builtin_amdgcn_logf(1.f + __builtin_amdgcn_exp2f(-1.4426950408889634f * fabsf(f))); }
__device__ __forceinline__ void ml_x1_unit(GCtx& c, const Args& a, int l, int h, int ch) {
    LAS float* sb = (LAS float*)c.scr; LAS float* si = sb + 128; LAS float* sw = sb + 256; LAS float* red = sb + 384;
    const float* gates = (const float*)(a.ws + WS_GATES);
    const int T0 = ch * 128;
    float fg = 0.f, ig = 0.f;
    if (c.tid < 128) { fg = gates[(size_t)(T0 + c.tid) * 8 + 4 + h]; ig = gates[(size_t)(T0 + c.tid) * 8 + h]; }
    u32x4 kx[2][4], vv[2]; ml_load_kv(c, a, h, T0, 0, kx, vv);
    ml_conv_to_lds(c, a, l, h);
    if (c.tid < 128) { sb[c.tid] = log_sigmoid(fg + a.gate_bias[l * 8 + 4 + h]); si[c.tid] = ig + a.gate_bias[l * 8 + h]; }
    gsync(c);
    if (c.wave == 0) {
        const float v0 = sb[2 * c.lane], v1 = sb[2 * c.lane + 1];
        float s = v0 + v1;
#pragma unroll
        for (int o = 1; o < 64; o <<= 1) { const float nb = __shfl_up(s, o); if (c.lane >= o) s += nb; }
        const float b0 = s - v1, b1 = s, bl = __shfl(s, 63);
        const float g0 = bl - b0 + si[2 * c.lane], g1 = bl - b1 + si[2 * c.lane + 1];
        float m = fmaxf(g0, g1);
#pragma unroll
        for (int o = 1; o < 64; o <<= 1) m = fmaxf(m, __shfl_xor(m, o));
        sw[2 * c.lane] = __expf(g0 - m); sw[2 * c.lane + 1] = __expf(g1 - m);
        if (c.lane == 0) { ((float*)(a.ws + WS_MLOC))[h * 128 + ch] = m; ((float*)(a.ws + WS_BC))[h * 128 + ch] = bl; }
    }
    gsync(c);
    ml_store_kv(c, a, l, h, T0, 0, kx, vv, sw);
    ml_load_kv(c, a, h, T0, 1, kx, vv);
    ml_store_kv(c, a, l, h, T0, 1, kx, vv, sw);
    gsync(c);
    kvt_mfma<128>(c, (float*)(a.ws + WS_KVML) + ((size_t)h * 128 + ch) * 4096);
    {
        LAS unsigned char* Kt = c.lds + LDS_KT;
        const int d = c.tid & 63, part = c.tid >> 6;
        float s = 0.f;
#pragma unroll
        for (int r = 0; r < 32; ++r) { const int row = part * 32 + r; s += bf2f(*(const LAS bf16_t*)(Kt + TILE_OFF(row, d >> 3) + (d & 7) * 2)); }
        red[part * 64 + d] = s;
    }
    gsync(c);
    if (c.tid < 64) ((float*)(a.ws + WS_NLOC))[((size_t)h * 128 + ch) * 64 + c.tid] = (red[c.tid] + red[64 + c.tid]) + (red[128 + c.tid] + red[192 + c.tid]);
    gsync(c);
}
struct MlPre { u32x4 qx[2][4]; };
__device__ __forceinline__ void ml_prefetch(const GCtx& c, const Args& a, int h, int ch, int wt, MlPre& p) {
    const bf16_t* proj = (const bf16_t*)(a.ws + WS_PROJ);
    const int i = c.lane & 15, g = c.lane >> 4, t = ch * 128 + wt * 16 + i;
    load_taps(proj, C_CQ + h * 64 + 8 * g, t, p.qx[0]); load_taps(proj, C_CQ + h * 64 + 32 + 8 * g, t, p.qx[1]);
}
__device__ __forceinline__ void ml_compute(const GCtx& c, const Args& a, int l, int h, int ch, int cc, int wt, float m_st, const f32x4 (&nw4)[4],
                                           const LAS float* sb, const LAS float* su, const LAS float* sM, const LAS float* sn) {
    bf16_t* proj = (bf16_t*)(a.ws + WS_PROJ);
    LAS unsigned char* Kt = c.lds + LDS_KT; LAS unsigned char* Vt = c.lds + LDS_VT;
    const LAS float* cv = (const LAS float*)c.scr + ML_CONV_OFF;
    const int i = c.lane & 15, g = c.lane >> 4, ql = wt * 16 + i, t = ch * 128 + ql;
    MlPre p; ml_prefetch(c, a, h, ch, wt, p);
    bf16x8 sf[4][2]; uint2 ot[4], gt[4];
    { const bf16_t* St = (const bf16_t*)(a.ws + WS_CPREV) + ((size_t)h * 128 + ch) * 4096;
#pragma unroll
      for (int et = 0; et < 4; ++et) { const bf16_t* rp = St + (size_t)(et * 16 + i) * 64 + 8 * g; sf[et][0] = *(const bf16x8*)rp; sf[et][1] = *(const bf16x8*)(rp + 32);
          ot[et] = *(const uint2*)(proj + (size_t)t * NP + C_CO + h * 64 + et * 16 + 4 * g); gt[et] = *(const uint2*)(proj + (size_t)t * NP + C_CG + h * 64 + et * 16 + 4 * g); } }
    bf16x8 qf[2]; float qn;
    {
        float q0[8], q1[8];
        conv8_raw(p.qx[0], cv, cv + 256, 8 * g, t, q0); conv8_raw(p.qx[1], cv, cv + 256, 32 + 8 * g, t, q1);
        qf[0] = __builtin_bit_cast(bf16x8, pack8(q0)); qf[1] = __builtin_bit_cast(bf16x8, pack8(q1));
        float s = 0.f;
#pragma unroll
        for (int j = 0; j < 8; ++j) s += q0[j] * sn[64 * cc + 8 * g + j] + q1[j] * sn[64 * cc + 32 + 8 * g + j];
        qn = grp4_sum(s);
    }
    const float Mq = sM[128 * cc + ql];
    const bool m0 = (4 * g + 0) <= i, m1 = (4 * g + 1) <= i, m2 = (4 * g + 2) <= i, m3 = (4 * g + 3) <= i;
    const int np = (wt >> 1) + 1;
    f32x4 S[16]; float rs = 0.f;
    st_pairs(Kt + 128 * cc * 128, qf, np, S, c.lane);
    f32x4 O[4];
#pragma unroll
    for (int et = 0; et < 4; ++et) O[et] = (f32x4){0.f, 0.f, 0.f, 0.f};
    bf16x8 vf[2][4];
    trfrag4(Vt, 128 * cc, vf[0], c.lane);
#pragma unroll
    for (int s = 0; s < 4; ++s) {
        if (s < np) {
            if (s + 1 < np) trfrag4(Vt, 128 * cc + 32 * (s + 1), vf[(s + 1) & 1], c.lane);
            __builtin_amdgcn_sched_barrier(0);
            u32x4 pw;
#pragma unroll
            for (int hh = 0; hh < 2; ++hh) { const int kt = 2 * s + hh;
                f32x4 v = S[kt];
                const f32x4 u4 = *(const LAS f32x4*)(su + 128 * cc + kt * 16 + 4 * g);
                v[0] *= __expf(u4[0] - Mq); v[1] *= __expf(u4[1] - Mq); v[2] *= __expf(u4[2] - Mq); v[3] *= __expf(u4[3] - Mq);
                if (kt == wt) { v[0] = m0 ? v[0] : 0.f; v[1] = m1 ? v[1] : 0.f; v[2] = m2 ? v[2] : 0.f; v[3] = m3 ? v[3] : 0.f; }
                if (kt > wt) v = (f32x4){0.f, 0.f, 0.f, 0.f};
                rs += (v[0] + v[1]) + (v[2] + v[3]);
                if (hh == 0) { pw.x = pk2(v[0], v[1]); pw.y = pk2(v[2], v[3]); } else { pw.z = pk2(v[0], v[1]); pw.w = pk2(v[2], v[3]); } }
            const bf16x8 pf = __builtin_bit_cast(bf16x8, pw);
#pragma unroll
            for (int et = 0; et < 4; ++et) O[et] = MFMA16(vf[s & 1][et], pf, O[et]);
            __builtin_amdgcn_sched_barrier(0);
        }
    }
    rs = grp4_sum(rs);
    const float winter = __expf(m_st - Mq);
    const float den = rs + winter * qn;
    const float inv = 1.f / fmaxf(fabsf(den), __expf(-(sb[128 * cc + ql] + Mq)));
#pragma unroll
    for (int et = 0; et < 4; ++et) {
        f32x4 x = (f32x4){0.f, 0.f, 0.f, 0.f};
        x = MFMA16(sf[et][0], qf[0], x); x = MFMA16(sf[et][1], qf[1], x);
        const uint2 ow = ot[et];
        f32x4 hv = (O[et] + x * winter) * inv;
        hv[0] *= sigmf(__uint_as_float(ow.x << 16)); hv[1] *= sigmf(__uint_as_float(ow.x & 0xffff0000u)); hv[2] *= sigmf(__uint_as_float(ow.y << 16)); hv[3] *= sigmf(__uint_as_float(ow.y & 0xffff0000u));
        O[et] = hv;
    }
    headnorm_store_pre(O, nw4, gt, proj + (size_t)t * NP + C_CG + h * 64, c.lane);
}
__device__ __forceinline__ void ml_x3_unit(GCtx& c, const Args& a, int l, int h, int ch0) {
    LAS float* sb = (LAS float*)c.scr; LAS float* su = sb + 256; LAS float* sM = sb + 512; LAS float* sn = sb + 768;
    const float* gates = (const float*)(a.ws + WS_GATES);
    const int T0 = ch0 * 128;
    const float fg = gates[(size_t)(T0 + c.tid) * 8 + 4 + h], ig = gates[(size_t)(T0 + c.tid) * 8 + h];
    const float m_st0 = ((const float*)(a.ws + WS_MPREV))[h * 128 + ch0], m_st1 = ((const float*)(a.ws + WS_MPREV))[h * 128 + ch0 + 1];
    float nst = 0.f; if (c.wave >= 2) nst = ((const float*)(a.ws + WS_NPREV))[((size_t)h * 128 + ch0 + (c.wave - 2)) * 64 + c.lane];
    u32x4 kx[2][4], vv[2]; ml_load_kv(c, a, h, T0, 0, kx, vv);
    ml_conv_to_lds(c, a, l, h);
    sb[c.tid] = log_sigmoid(fg + a.gate_bias[l * 8 + 4 + h]); su[c.tid] = ig + a.gate_bias[l * 8 + h];
    if (c.wave >= 2) sn[(c.wave - 2) * 64 + c.lane] = nst;
    gsync(c);
    if (c.wave < 2) {
        LAS float* b = sb + 128 * c.wave; LAS float* u = su + 128 * c.wave; LAS float* M = sM + 128 * c.wave;
        const float m_st = c.wave ? m_st1 : m_st0;
        const float v0 = b[2 * c.lane], v1 = b[2 * c.lane + 1];
        float s = v0 + v1;
#pragma unroll
        for (int o = 1; o < 64; o <<= 1) { const float nb = __shfl_up(s, o); if (c.lane >= o) s += nb; }
        const float b0 = s - v1, b1 = s;
        const float u0 = u[2 * c.lane] - b0, u1 = u[2 * c.lane + 1] - b1;
        float m = fmaxf(u0, u1);
#pragma unroll
        for (int o = 1; o < 64; o <<= 1) { const float nb = __shfl_up(m, o); if (c.lane >= o) m = fmaxf(m, nb); }
        float mprev = __shfl_up(m, 1); if (c.lane == 0) mprev = -INFINITY;
        b[2 * c.lane] = b0; b[2 * c.lane + 1] = b1; u[2 * c.lane] = u0; u[2 * c.lane + 1] = u1;
        M[2 * c.lane] = fmaxf(m_st, fmaxf(mprev, u0)); M[2 * c.lane + 1] = fmaxf(m_st, m);
    }
    ml_store_kv(c, a, l, h, T0, 0, kx, vv, nullptr);
#pragma unroll 1
    for (int half = 1; half < 4; ++half) { ml_load_kv(c, a, h, T0, half, kx, vv); ml_store_kv(c, a, l, h, T0, half, kx, vv, nullptr); }
    gsync(c);
    f32x4 nw4[4];
#pragma unroll
    for (int et = 0; et < 4; ++et) nw4[et] = *(const f32x4*)(a.ml_nw + (size_t)l * 256 + h * 64 + et * 16 + 4 * (c.lane >> 4));
#pragma unroll 1
    for (int k = 0; k < 4; ++k) {
        UNIT_FENCE(c);
        const int cc = k >> 1;
        ml_compute(c, a, l, h, ch0 + cc, cc, (k & 1) ? c.wave : 7 - c.wave, cc ? m_st1 : m_st0, nw4, sb, su, sM, sn);
    }
    gsync(c);
}

__device__ __forceinline__ void ret_scan_unit(GCtx& c, const Args& a, int h, int part) {
    const float* kv = (const float*)(a.ws + WS_KVRET) + (size_t)h * 64 * 4096 + part * GT + c.tid;
    bf16_t* rp = (bf16_t*)(a.ws + WS_RPREV) + (size_t)h * 64 * 4096 + part * GT + c.tid;
    const float dec = exp2f(256.f * log2f(1.f - exp2f(-5.f - (float)h)));
    float st = 0.f;
    for (int c0 = 0; c0 < 64; c0 += 32) {
        float v[32];
#pragma unroll
        for (int j = 0; j < 32; ++j) v[j] = kv[(size_t)(c0 + j) * 4096];
#pragma unroll
        for (int j = 0; j < 32; ++j) { rp[(size_t)(c0 + j) * 4096] = f2bf(st); st = fmaf(dec, st, v[j]); }
    }
}
__device__ __forceinline__ void ml_scan_unit(GCtx& c, const Args& a, int h, int part) {
    LAS float* sa = (LAS float*)c.scr; LAS float* swl = sa + 128;
    const float* mloc = (const float*)(a.ws + WS_MLOC) + h * 128; const float* bc = (const float*)(a.ws + WS_BC) + h * 128;
    if (c.wave == 0) {
        const float B0 = bc[2 * c.lane], B1 = bc[2 * c.lane + 1], L0 = mloc[2 * c.lane], L1 = mloc[2 * c.lane + 1];
        float s = B0 + B1;
#pragma unroll
        for (int o = 1; o < 64; o <<= 1) { const float nb = __shfl_up(s, o); if (c.lane >= o) s += nb; }
        const float pb0 = s - (B0 + B1), pb1 = pb0 + B0, pb2 = s;
        const float y0 = L0 - pb1, y1 = L1 - pb2;
        float mx = fmaxf(y0, y1);
#pragma unroll
        for (int o = 1; o < 64; o <<= 1) { const float nb = __shfl_up(mx, o); if (c.lane >= o) mx = fmaxf(mx, nb); }
        float mxp = __shfl_up(mx, 1); if (c.lane == 0) mxp = -INFINITY;
        const float X0 = fmaxf(0.f, mxp), X1 = fmaxf(X0, y0), X2 = fmaxf(X1, y1);
        const float m0 = pb0 + X0, m1 = pb1 + X1, m2 = pb2 + X2;
        sa[2 * c.lane] = __expf(B0 + m0 - m1); swl[2 * c.lane] = __expf(L0 - m1);
        sa[2 * c.lane + 1] = __expf(B1 + m1 - m2); swl[2 * c.lane + 1] = __expf(L1 - m2);
        if (part == 0) { float* mp = (float*)(a.ws + WS_MPREV) + h * 128; mp[2 * c.lane] = m0; mp[2 * c.lane + 1] = m1; }
    }
    gsync(c);
    const int idx = part * GT + c.tid;
    if (idx < 4160) {
        const bool isC = idx < 4096;
        const float* src = isC ? (const float*)(a.ws + WS_KVML) + (size_t)h * 128 * 4096 + idx : (const float*)(a.ws + WS_NLOC) + (size_t)h * 128 * 64 + (idx - 4096);
        const size_t sstride = isC ? 4096 : 64;
        bf16_t* cp = (bf16_t*)(a.ws + WS_CPREV) + (size_t)h * 128 * 4096 + idx;
        float* np = (float*)(a.ws + WS_NPREV) + (size_t)h * 128 * 64 + (idx - 4096);
        float st = 0.f;
        for (int c0 = 0; c0 < 128; c0 += 32) {
            float v[32];
#pragma unroll
            for (int j = 0; j < 32; ++j) v[j] = src[(size_t)(c0 + j) * sstride];
#pragma unroll
            for (int j = 0; j < 32; ++j) {
                if (isC) cp[(size_t)(c0 + j) * 4096] = f2bf(st); else np[(size_t)(c0 + j) * 64] = st;
                st = sa[c0 + j] * st + swl[c0 + j] * v[j];
            }
        }
    }
    gsync(c);
}
#define CW_CNT(l) (4096 + (l) * 512)
#define MOBA_C1 0.18033688011112042f
__device__ __forceinline__ int list_off(int n) { return 16384 * n - 128 * n * (n + 1); }
__device__ __forceinline__ bool better(float v, int n, float w, int m) { return v > w || (v == w && n < m); }
__device__ __forceinline__ void top3_insert(float v, int n, float& v0, int& i0, float& v1, int& i1, float& v2, int& i2) {
    const bool b0 = better(v, n, v0, i0), b1 = better(v, n, v1, i1), b2 = better(v, n, v2, i2);
    const float nv2 = b1 ? v1 : (b2 ? v : v2); const int ni2 = b1 ? i1 : (b2 ? n : i2);
    const float nv1 = b0 ? v0 : (b1 ? v : v1); const int ni1 = b0 ? i0 : (b1 ? n : i1);
    const float nv0 = b0 ? v : v0;             const int ni0 = b0 ? n : i0;
    v0 = nv0; i0 = ni0; v1 = nv1; i1 = ni1; v2 = nv2; i2 = ni2;
}
__device__ __forceinline__ void load_qf(const bf16_t* qrow, bf16x8 (&qf)[2], int g) { qf[0] = *(const bf16x8*)(qrow + 8 * g); qf[1] = *(const bf16x8*)(qrow + 32 + 8 * g); }

__device__ __forceinline__ void moba_gate_unit(GCtx& c, const Args& a, int l, int h, int qc) {
    const int j = qc >> 1;
    if (j == 0) return;
    const bf16_t* proj = (const bf16_t*)(a.ws + WS_PROJ); const float* kmp = (const float*)(a.ws + WS_KMP);
    LAS unsigned char* KM = c.lds + LDS_KT;
    LAS unsigned* hist = (LAS unsigned*)c.scr; LAS unsigned* base = hist + 64;
    unsigned* gcnt = (unsigned*)(a.ws + WS_CTL) + CW_CNT(l) + h * 64;
    unsigned* list = (unsigned*)(a.ws + WS_LIST) + (size_t)h * LIST_PER_HEAD;
    const int i = c.lane & 15, g = c.lane >> 4;
    bf16x8 qf[2][2];
#pragma unroll
    for (int r = 0; r < 2; ++r) load_qf(proj + (size_t)(qc * 128 + r * 64 + c.wave * 16 + i) * NP + C_AQ + h * 64, qf[r], g);
    {
        f32x4 a0[2], a1[2], b0[2], b1[2];
#pragma unroll
        for (int q = 0; q < 2; ++q) { const int it = c.tid + q * GT, n = it >> 3, c16 = it & 7;
            const float* p0 = kmp + (size_t)(2 * n) * 512 + h * 64 + 8 * c16; const float* p1 = p0 + 512;
            a0[q] = *(const f32x4*)p0; a1[q] = *(const f32x4*)(p0 + 4); b0[q] = *(const f32x4*)p1; b1[q] = *(const f32x4*)(p1 + 4); }
#pragma unroll
        for (int q = 0; q < 2; ++q) { const int it = c.tid + q * GT, n = it >> 3, c16 = it & 7;
            float v[8];
#pragma unroll
            for (int e = 0; e < 4; ++e) { v[e] = (a0[q][e] + b0[q][e]) * (1.f / 256.f); v[4 + e] = (a1[q][e] + b1[q][e]) * (1.f / 256.f); }
            tile_store8(KM, n, c16, v); }
    }
    if (c.tid < 64) hist[c.tid] = 0u;
    gsync(c);
    const int nsel = j < 3 ? j : 3;
    const bool valid = g < nsel;
    int nsl[2]; unsigned pos[2];
#pragma unroll
    for (int r = 0; r < 2; ++r) {
        float v0 = -INFINITY, v1 = -INFINITY, v2 = -INFINITY; int i0 = 0, i1 = 0, i2 = 0;
#pragma unroll
        for (int nt = 0; nt < 4; ++nt) {
            if (nt * 16 < j) {
                const f32x4 gt = st_tile(KM, nt * 16, qf[r], c.lane);
#pragma unroll
                for (int q = 0; q < 4; ++q) { const int n = nt * 16 + 4 * g + q; top3_insert(n < j ? gt[q] : -INFINITY, n, v0, i0, v1, i1, v2, i2); }
            }
        }
#pragma unroll
        for (int off = 16; off <= 32; off <<= 1) {
            const float p0 = __shfl_xor(v0, off), p1 = __shfl_xor(v1, off), p2 = __shfl_xor(v2, off);
            const int q0 = __shfl_xor(i0, off), q1 = __shfl_xor(i1, off), q2 = __shfl_xor(i2, off);
            top3_insert(p0, q0, v0, i0, v1, i1, v2, i2); top3_insert(p1, q1, v0, i0, v1, i1, v2, i2); top3_insert(p2, q2, v0, i0, v1, i1, v2, i2);
        }
        nsl[r] = g == 0 ? i0 : (g == 1 ? i1 : i2);
        pos[r] = 0u;
        if (valid) pos[r] = __hip_atomic_fetch_add(hist + nsl[r], 1u, __ATOMIC_RELAXED, __HIP_MEMORY_SCOPE_WORKGROUP);
    }
    gsync(c);
    if (c.tid < 64) { const unsigned cn = hist[c.tid]; base[c.tid] = cn ? __hip_atomic_fetch_add(gcnt + c.tid, cn, __ATOMIC_RELAXED, __HIP_MEMORY_SCOPE_AGENT) : 0u; }
    gsync(c);
    if (valid) {
#pragma unroll
        for (int r = 0; r < 2; ++r) { const int t = qc * 128 + r * 64 + c.wave * 16 + i; list[list_off(nsl[r]) + base[nsl[r]] + pos[r]] = (unsigned)(t * 4 + g); }
    }
    gsync(c);
}

__device__ __forceinline__ bf16x8 moba_cfrag(float sl2, int lane) {
    const int i = lane & 15, g = lane >> 4;
    float v[8];
#pragma unroll
    for (int j = 0; j < 4; ++j) { const float w = i == 0 ? exp2f(sl2 * (float)(4 * g + j - 15)) : 0.f; v[j] = w; v[4 + j] = w; }
    return __builtin_bit_cast(bf16x8, pack8(v));
}
__device__ __forceinline__ void pv_step_l(LAS unsigned char* Vt, int key0, const f32x4& s0, const f32x4& s1, f32x4 (&O)[4], f32x4& L, const bf16x8 cfrag, int lane) {
    u32x4 pw; pw.x = pg8::cvt_pk_bf16(s0[0], s0[1]); pw.y = pg8::cvt_pk_bf16(s0[2], s0[3]); pw.z = pg8::cvt_pk_bf16(s1[0], s1[1]); pw.w = pg8::cvt_pk_bf16(s1[2], s1[3]);
    const bf16x8 pf = __builtin_bit_cast(bf16x8, pw);
#pragma unroll
    for (int et = 0; et < 4; ++et) O[et] = MFMA16(tile_trfrag(Vt, key0, et, lane), pf, O[et]);
    L = MFMA16(cfrag, pf, L);
}
__device__ __forceinline__ void moba_sel_wave(const GCtx& c, const Args& a, int h, int n, unsigned entry, bool valid, const bf16x8 (&qf)[2], float sl2, const bf16x8 cfrag) {
    LAS unsigned char* Kt = c.lds + LDS_KT; LAS unsigned char* Vt = c.lds + LDS_VT;
    const int g = c.lane >> 4;
    const int t = (int)(entry >> 2), slot = (int)(entry & 3u);
    f32x4 S[16];
    st_pairs(Kt, qf, 8, S, c.lane);
    float am = -INFINITY;
#pragma unroll
    for (int kt = 0; kt < 16; ++kt) am = fmaxf(am, fmaxf(fmaxf(S[kt][0], S[kt][1]), fmaxf(S[kt][2], S[kt][3])));
    am = grp4_max(am) * MOBA_C1;
    f32x4 O[4], L = (f32x4){0.f, 0.f, 0.f, 0.f};
#pragma unroll
    for (int et = 0; et < 4; ++et) O[et] = (f32x4){0.f, 0.f, 0.f, 0.f};
    bf16x8 vf[2][4];
    trfrag4(Vt, 0, vf[0], c.lane);
#pragma unroll
    for (int s = 0; s < 8; ++s) {
        if (s + 1 < 8) trfrag4(Vt, 32 * (s + 1), vf[(s + 1) & 1], c.lane);
        __builtin_amdgcn_sched_barrier(0);
        u32x4 pw;
#pragma unroll
        for (int hh = 0; hh < 2; ++hh) { const int kt = 2 * s + hh;
            const float off = sl2 * (float)(16 * (kt - 15)) - am;
            const f32x4 v = S[kt];
            const float p0 = __builtin_amdgcn_exp2f(fmaf(v[0], MOBA_C1, off)), p1 = __builtin_amdgcn_exp2f(fmaf(v[1], MOBA_C1, off)), p2 = __builtin_amdgcn_exp2f(fmaf(v[2], MOBA_C1, off)), p3 = __builtin_amdgcn_exp2f(fmaf(v[3], MOBA_C1, off));
            if (hh == 0) { pw.x = pk2(p0, p1); pw.y = pk2(p2, p3); } else { pw.z = pk2(p0, p1); pw.w = pk2(p2, p3); } }
        const bf16x8 pf = __builtin_bit_cast(bf16x8, pw);
#pragma unroll
        for (int et = 0; et < 4; ++et) O[et] = MFMA16(vf[s & 1][et], pf, O[et]);
        L = MFMA16(cfrag, pf, L);
        __builtin_amdgcn_sched_barrier(0);
    }
    const float ls = __shfl(L[0], c.lane & 15);
    if (valid) {
        const float inv = 1.f / ls;
        const size_t pidx = ((size_t)t * 8 + h) * 3 + slot;
        bf16_t* po = (bf16_t*)(a.ws + WS_PART) + pidx * 64;
#pragma unroll
        for (int et = 0; et < 4; ++et) { uint2 o; o.x = pk2(O[et][0] * inv, O[et][1] * inv); o.y = pk2(O[et][2] * inv, O[et][3] * inv); *(uint2*)(po + et * 16 + 4 * g) = o; }
        if (g == 0) *(float2*)((float*)(a.ws + WS_PML) + pidx * 2) = make_float2(am + sl2 * (float)(n * 256 + 255 - t), ls);
    }
}
__device__ __forceinline__ void moba_load_kv(const GCtx& c, const Args& a, int h, int n, u32x4 (&kr)[8], u32x4 (&vr)[8]) {
    const bf16_t* proj = (const bf16_t*)(a.ws + WS_PROJ);
#pragma unroll
    for (int q = 0; q < 8; ++q) { const int it = c.tid + q * GT, row = it >> 3, c16 = it & 7;
        const bf16_t* rp = proj + (size_t)(n * 256 + row) * NP + h * 64 + 8 * c16; kr[q] = *(const u32x4*)(rp + C_AK); vr[q] = *(const u32x4*)(rp + C_AV); }
}
__device__ __forceinline__ void moba_store_kv(const GCtx& c, const u32x4 (&kr)[8], const u32x4 (&vr)[8], float sl2) {
    LAS unsigned char* Kt = c.lds + LDS_KT; LAS unsigned char* Vt = c.lds + LDS_VT;
    const float cf = exp2f(sl2 * (float)(((c.tid >> 3) & 15) - 15));
#pragma unroll
    for (int q = 0; q < 8; ++q) { const int it = c.tid + q * GT, row = it >> 3, c16 = it & 7;
        *(LAS u32x4*)(Kt + TILE_OFF(row, c16)) = kr[q];
        float v[8]; unpack8(vr[q], v);
#pragma unroll
        for (int j = 0; j < 8; ++j) v[j] *= cf;
        tile_store8(Vt, row, c16, v); }
}

struct OwnPre { bf16x8 q0, q1; float2 ml0, ml1, ml2; uint2 gt[4]; };
__device__ __forceinline__ void own_prefetch(const GCtx& c, const Args& a, int h, int j, int wt, OwnPre& p) {
    const bf16_t* proj = (const bf16_t*)(a.ws + WS_PROJ);
    const int i = c.lane & 15, g = c.lane >> 4, t = j * 256 + wt * 16 + i, nsel = j < 3 ? j : 3;
    const bf16_t* qrow = proj + (size_t)t * NP + C_AQ + h * 64;
    p.q0 = *(const bf16x8*)(qrow + 8 * g); p.q1 = *(const bf16x8*)(qrow + 32 + 8 * g);
    const size_t pbase = ((size_t)t * 8 + h) * 3;
    const float2* pml = (const float2*)((const float*)(a.ws + WS_PML)) + pbase;
    p.ml0 = make_float2(-INFINITY, 0.f); p.ml1 = p.ml0; p.ml2 = p.ml0;
    if (nsel > 0) p.ml0 = pml[0];
    if (nsel > 1) p.ml1 = pml[1];
    if (nsel > 2) p.ml2 = pml[2];
#pragma unroll
    for (int et = 0; et < 4; ++et) p.gt[et] = *(const uint2*)(proj + (size_t)t * NP + C_AG + h * 64 + et * 16 + 4 * g);
}
__device__ __forceinline__ void own_compute(const GCtx& c, const Args& a, int h, int j, int wt, const OwnPre& p) {
    bf16_t* proj = (bf16_t*)(a.ws + WS_PROJ);
    LAS unsigned char* Kt = c.lds + LDS_KT; LAS unsigned char* Vt = c.lds + LDS_VT;
    const int i = c.lane & 15, g = c.lane >> 4, ql = wt * 16 + i, t = j * 256 + ql, nsel = j < 3 ? j : 3;
    uint2 pw[3][4];
    { const bf16_t* po = (const bf16_t*)(a.ws + WS_PART) + (((size_t)t * 8 + h) * 3) * 64;
#pragma unroll
      for (int s = 0; s < 3; ++s)
#pragma unroll
          for (int et = 0; et < 4; ++et) { pw[s][et] = make_uint2(0u, 0u); if (s < nsel) pw[s][et] = *(const uint2*)(po + s * 64 + et * 16 + 4 * g); } }
    bf16x8 qf[2]; qf[0] = p.q0; qf[1] = p.q1;
    const float sl2 = exp2f(-(float)(h + 1)) * 1.4426950408889634f;
    const bf16x8 cfrag = moba_cfrag(sl2, c.lane);
    const bool m0 = (4 * g + 0) <= i, m1 = (4 * g + 1) <= i, m2 = (4 * g + 2) <= i, m3 = (4 * g + 3) <= i;
    const int np = (wt >> 1) + 1;
    f32x4 S[16];
    st_pairs(Kt, qf, np, S, c.lane);
    float m = -INFINITY;
#pragma unroll
    for (int kt = 0; kt < 16; ++kt) {
        if (kt <= wt) {
            f32x4 s = S[kt];
            if (kt == wt) { s[0] = m0 ? s[0] : -INFINITY; s[1] = m1 ? s[1] : -INFINITY; s[2] = m2 ? s[2] : -INFINITY; s[3] = m3 ? s[3] : -INFINITY; S[kt] = s; }
            m = fmaxf(m, fmaxf(fmaxf(s[0], s[1]), fmaxf(s[2], s[3])));
        }
    }
    const float mraw = grp4_max(m);
    const float ob = fmaf(mraw, -MOBA_C1, sl2 * (float)(15 - ql));
    m = mraw * MOBA_C1;
    asm volatile("" : "+v"(m));
    f32x4 O[4], L = (f32x4){0.f, 0.f, 0.f, 0.f};
#pragma unroll
    for (int et = 0; et < 4; ++et) O[et] = (f32x4){0.f, 0.f, 0.f, 0.f};
    bf16x8 vf[2][4];
    trfrag4(Vt, 0, vf[0], c.lane);
#pragma unroll
    for (int s = 0; s < 8; ++s) {
        if (s < np) {
            if (s + 1 < np) trfrag4(Vt, 32 * (s + 1), vf[(s + 1) & 1], c.lane);
            __builtin_amdgcn_sched_barrier(0);
            u32x4 pw;
#pragma unroll
            for (int hh = 0; hh < 2; ++hh) { const int kt = 2 * s + hh;
                const float off = ob + sl2 * (float)(16 * kt);
                const f32x4 v = S[kt];
                float p0 = __builtin_amdgcn_exp2f(fmaf(v[0], MOBA_C1, off)), p1 = __builtin_amdgcn_exp2f(fmaf(v[1], MOBA_C1, off)), p2 = __builtin_amdgcn_exp2f(fmaf(v[2], MOBA_C1, off)), p3 = __builtin_amdgcn_exp2f(fmaf(v[3], MOBA_C1, off));
                if (kt > wt) { p0 = 0.f; p1 = 0.f; p2 = 0.f; p3 = 0.f; }
                if (hh == 0) { pw.x = pk2(p0, p1); pw.y = pk2(p2, p3); } else { pw.z = pk2(p0, p1); pw.w = pk2(p2, p3); } }
            const bf16x8 pf = __builtin_bit_cast(bf16x8, pw);
#pragma unroll
            for (int et = 0; et < 4; ++et) O[et] = MFMA16(vf[s & 1][et], pf, O[et]);
            L = MFMA16(cfrag, pf, L);
            __builtin_amdgcn_sched_barrier(0);
        }
    }
    const float ls = __shfl(L[0], c.lane & 15);
    const float mt = fmaxf(fmaxf(m, p.ml0.x), fmaxf(p.ml1.x, p.ml2.x));
    const float aown = __builtin_amdgcn_exp2f(m - mt);
    const float a0 = nsel > 0 ? __builtin_amdgcn_exp2f(p.ml0.x - mt) * p.ml0.y : 0.f, a1 = nsel > 1 ? __builtin_amdgcn_exp2f(p.ml1.x - mt) * p.ml1.y : 0.f, a2 = nsel > 2 ? __builtin_amdgcn_exp2f(p.ml2.x - mt) * p.ml2.y : 0.f;
    const float inv = 1.f / (ls * aown + a0 + a1 + a2);
#pragma unroll
    for (int et = 0; et < 4; ++et) {
        const int e = et * 16 + 4 * g;
        f32x4 o = O[et] * aown;
        { const uint2 w = pw[0][et]; o[0] += a0 * __uint_as_float(w.x << 16); o[1] += a0 * __uint_as_float(w.x & 0xffff0000u); o[2] += a0 * __uint_as_float(w.y << 16); o[3] += a0 * __uint_as_float(w.y & 0xffff0000u); }
        { const uint2 w = pw[1][et]; o[0] += a1 * __uint_as_float(w.x << 16); o[1] += a1 * __uint_as_float(w.x & 0xffff0000u); o[2] += a1 * __uint_as_float(w.y << 16); o[3] += a1 * __uint_as_float(w.y & 0xffff0000u); }
        { const uint2 w = pw[2][et]; o[0] += a2 * __uint_as_float(w.x << 16); o[1] += a2 * __uint_as_float(w.x & 0xffff0000u); o[2] += a2 * __uint_as_float(w.y << 16); o[3] += a2 * __uint_as_float(w.y & 0xffff0000u); }
        const uint2 gw = p.gt[et];
        uint2 ow;
        ow.x = pk2(o[0] * inv * siluf(__uint_as_float(gw.x << 16)), o[1] * inv * siluf(__uint_as_float(gw.x & 0xffff0000u)));
        ow.y = pk2(o[2] * inv * siluf(__uint_as_float(gw.y << 16)), o[3] * inv * siluf(__uint_as_float(gw.y & 0xffff0000u)));
        *(uint2*)(proj + (size_t)t * NP + C_AG + h * 64 + e) = ow;
    }
}
__device__ __forceinline__ void moba_own_unit(GCtx& c, const Args& a, int h, int j) {
    OwnPre cur; own_prefetch(c, a, h, j, tile16_of(c.wave, 0), cur);
    { u32x4 kr[8], vr[8]; moba_load_kv(c, a, h, j, kr, vr); moba_store_kv(c, kr, vr, exp2f(-(float)(h + 1)) * 1.4426950408889634f); }
    gsync(c);
#pragma unroll 1
    for (int k = 0; k < 4; ++k) {
        UNIT_FENCE(c);
        OwnPre nxt; own_prefetch(c, a, h, j, tile16_of(c.wave, k < 3 ? k + 1 : 3), nxt);
        own_compute(c, a, h, j, tile16_of(c.wave, k), cur);
        cur = nxt;
    }
    gsync(c);
}

#define SCAN_TILE_EQ 4
#define SEL_STAGE_W 2
struct SelRun { int valid, pair, k0, k1, pnext; };
__device__ __forceinline__ SelRun sel_find_run(const LAS unsigned* pre, int p, int p1) {
    SelRun r; r.valid = 0; r.pair = 0; r.k0 = 0; r.k1 = 0; r.pnext = p1;
    while (p < p1) {
        int lo = 0, hi = 511;
        while (lo < hi) { const int mid = (lo + hi) >> 1; if (pre[mid] > (unsigned)p) hi = mid; else lo = mid + 1; }
        const int before = lo ? (int)pre[lo - 1] : 0, end = (int)pre[lo], tiles = end - before - SEL_STAGE_W;
        int k0 = p - before - SEL_STAGE_W; k0 = k0 < 0 ? 0 : k0;
        int k1 = p1 - before - SEL_STAGE_W; k1 = k1 > tiles ? tiles : k1;
        p = end < p1 ? end : p1;
        if (k1 > k0) { r.valid = 1; r.pair = lo; r.k0 = k0; r.k1 = k1; r.pnext = p; return r; }
    }
    return r;
}
__device__ __forceinline__ void moba_sel_prefix(const Ctx& c, const Args& a, int l) {
    LAS unsigned* pre = (LAS unsigned*)(c.lds + LDS_PRE);
    const unsigned* gcnt = (const unsigned*)(a.ws + WS_CTL) + CW_CNT(l);
    const unsigned cntp = __hip_atomic_load(gcnt + c.tid, __ATOMIC_RELAXED, __HIP_MEMORY_SCOPE_AGENT);
    unsigned v = cntp ? ((cntp + 63u) >> 6) + SEL_STAGE_W : 0u;
#pragma unroll
    for (int o = 1; o < 64; o <<= 1) { const unsigned nb = __shfl_up(v, o); if (c.lane >= o) v += nb; }
    if (c.lane == 63) pre[512 + c.wave] = v;
    __syncthreads();
    unsigned woff = 0;
    for (int w = 0; w < c.wave; ++w) woff += pre[512 + w];
    pre[c.tid] = v + woff;
    __syncthreads();
}
__device__ __forceinline__ void moba_sel_phase(GCtx& c, const Args& a, int l, int nscan) {
    const LAS unsigned* pre = (const LAS unsigned*)((LAS unsigned char*)0 + LDS_PRE);
    const bf16_t* proj = (const bf16_t*)(a.ws + WS_PROJ);
    const unsigned* gcnt = (const unsigned*)(a.ws + WS_CTL) + CW_CNT(l);
    const int TW = (int)pre[511];
    const int q = (TW + SCAN_TILE_EQ * nscan + c.ng - 1) / c.ng;
    int p0 = c.gg * q - SCAN_TILE_EQ * (c.gg < nscan ? c.gg : nscan), p1 = (c.gg + 1) * q - SCAN_TILE_EQ * (c.gg + 1 < nscan ? c.gg + 1 : nscan);
    p0 = p0 < 0 ? 0 : (p0 > TW ? TW : p0); p1 = p1 < 0 ? 0 : (p1 > TW ? TW : p1);
    const int i = c.lane & 15, g = c.lane >> 4;
    SelRun cur = sel_find_run(pre, p0, p1);
    if (cur.valid) { u32x4 kr[8], vr[8]; moba_load_kv(c, a, cur.pair >> 6, cur.pair & 63, kr, vr); moba_store_kv(c, kr, vr, exp2f(-(float)((cur.pair >> 6) + 1)) * 1.4426950408889634f); }
    gsync(c);
    while (cur.valid) {
        const SelRun nxt = sel_find_run(pre, cur.pnext, p1);
        u32x4 kr[8];
        if (nxt.valid) {
            const int hn = nxt.pair >> 6, nn = nxt.pair & 63;
#pragma unroll
            for (int q = 0; q < 8; ++q) { const int it = c.tid + q * GT, row = it >> 3, c16 = it & 7; kr[q] = *(const u32x4*)(proj + (size_t)(nn * 256 + row) * NP + hn * 64 + 8 * c16 + C_AK); }
        }
        const int h = cur.pair >> 6, n = cur.pair & 63;
        const float sl2 = exp2f(-(float)(h + 1)) * 1.4426950408889634f;
        const bf16x8 cfrag = moba_cfrag(sl2, c.lane);
        const unsigned cn = __hip_atomic_load(gcnt + cur.pair, __ATOMIC_RELAXED, __HIP_MEMORY_SCOPE_AGENT);
        const unsigned* list = (const unsigned*)(a.ws + WS_LIST) + (size_t)h * LIST_PER_HEAD + list_off(n);
        const unsigned ebase = (unsigned)(cur.k0 * 64 + c.wave * 16 + i);
        const unsigned efirst = (unsigned)(cur.k0 * 64);
        unsigned e_cur = ebase, e_nxt = ebase + 64u;
        unsigned ent_cur = list[e_cur < cn ? e_cur : efirst], ent_nxt = list[e_nxt < cn ? e_nxt : efirst];
        bf16x8 qf[2]; load_qf(proj + (size_t)(ent_cur >> 2) * NP + C_AQ + h * 64, qf, g);
        for (int k = cur.k0; k < cur.k1; ++k) {
            bf16x8 qn[2]; load_qf(proj + (size_t)(ent_nxt >> 2) * NP + C_AQ + h * 64, qn, g);
            const unsigned e_nn = e_nxt + 64u;
            const unsigned ent_nn = list[e_nn < cn ? e_nn : efirst];
            const bool valid = e_cur < cn;
            if (__any(valid)) moba_sel_wave(c, a, h, n, ent_cur, valid, qf, sl2, cfrag);
            e_cur = e_nxt; e_nxt = e_nn; ent_cur = ent_nxt; ent_nxt = ent_nn; qf[0] = qn[0]; qf[1] = qn[1];
        }
        gsync(c);
        if (nxt.valid) {
            const int hn = nxt.pair >> 6, nn = nxt.pair & 63;
            u32x4 vr[8];
#pragma unroll
            for (int q = 0; q < 8; ++q) { const int it = c.tid + q * GT, row = it >> 3, c16 = it & 7; vr[q] = *(const u32x4*)(proj + (size_t)(nn * 256 + row) * NP + hn * 64 + 8 * c16 + C_AV); }
            moba_store_kv(c, kr, vr, exp2f(-(float)(hn + 1)) * 1.4426950408889634f);
        }
        gsync(c);
        cur = nxt;
    }
}
__device__ __forceinline__ void phase_pb(const Ctx& c, const Args& a, int l) {
    const bool tail = c.bid < N_TAIL_WG;
    if (tail) gemm_tail(c, a);
    if (l >= 1) convert_w_out(c, a, l);
    __syncthreads();
    GCtx g = make_group(c);
    const int gi = tail ? g.gg : g.gg - 2 * N_TAIL_WG;
    const int nu = tail ? 1 : (gi >= 128 && gi < 256 ? 5 : 4), us = g.ng - 2 * N_TAIL_WG;
    for (int k = 0; k < nu; ++k) {
        const int u = tail ? 1536 + gi : (k < 4 ? gi + k * us : 1664 + (gi - 128));
        UNIT_FENCE(g);
        if (u < 512) { PSUB_T0(c, 21); ml_x1_unit(g, a, l, u >> 7, u & 127); PSUB_T1(c, 21); }
        else if (u < 1536) { PSUB_T0(c, 22); moba_gate_unit(g, a, l, (u - 512) >> 7, (u - 512) & 127); PSUB_T1(c, 22); }
        else { PSUB_T0(c, 20); ret_x1_unit(g, a, (u - 1536) >> 6, (u - 1536) & 63); PSUB_T1(c, 20); }
    }
}
#define N_RET_SCAN 64
#define N_ML_SCAN 68
__device__ __forceinline__ void phase_pc(const Ctx& c, const Args& a, int l) {
    moba_sel_prefix(c, a, l);
    GCtx g = make_group(c);
    if (g.gg < N_RET_SCAN) ret_scan_unit(g, a, g.gg >> 4, g.gg & 15);
    else if (g.gg < N_RET_SCAN + N_ML_SCAN) ml_scan_unit(g, a, (g.gg - N_RET_SCAN) / 17, (g.gg - N_RET_SCAN) % 17);
    UNIT_FENCE(g);
    PSUB_T0(c, 5);
    moba_sel_phase(g, a, l, N_RET_SCAN + N_ML_SCAN);
    PSUB_T1(c, 5);
}
__device__ __forceinline__ void phase_pd(const Ctx& c, const Args& a, int l) {
    PSUB_T0(c, 13);
    GCtx g = make_group(c);
    UNIT_FENCE(g);
    PSUB_T0(c, 10); moba_own_unit(g, a, g.gg >> 6, g.gg & 63); PSUB_T1(c, 10);
    UNIT_FENCE(g);
    if (g.gg < 256) { PSUB_T0(c, 11); ret_x3_unit(g, a, l, g.gg >> 6, g.gg & 63); PSUB_T1(c, 11); }
    else {
        PSUB_T0(c, 12);
        { const int u = 2 * (g.gg - 256); UNIT_FENCE(g); ml_x3_unit(g, a, l, u >> 7, u & 127); }
        PSUB_T1(c, 12);
    }
    PSUB_T1(c, 13);
    PSUB_T0(c, 14);
    if (l + 1 < DEPTH) { __syncthreads(); convert_w_in(c, a, l + 1); }
    PSUB_T1(c, 14);
}
__global__ void __launch_bounds__(NTHREADS, 2) mk(Args args) {
    extern __shared__ __attribute__((aligned(16))) unsigned char lds_raw[];
    LAS unsigned char* lds = (LAS unsigned char*)lds_raw;
    const bool t0_ = threadIdx.x == 0;
    const int wave0_ = __builtin_amdgcn_readfirstlane((int)threadIdx.x >> 6);
    volatile LAS unsigned* MISC = (volatile LAS unsigned*)(lds + LDS_CTL_OFF);
    if (threadIdx.x < 64) MISC[threadIdx.x] = 0u;
    __syncthreads();
    XcdBarrier bar; bar.bar = (unsigned*)(args.ws + WS_CTL) + CW_BAR; bar.x = 0; bar.st = MISC + 8;
    const bool multi = (args.ph_hi - args.ph_lo) > 1;
    if (multi) bar = xcd_barrier_post((unsigned*)(args.ws + WS_CTL) + CW_BAR, MISC + 8);
#ifdef PROBE_SEL
    unsigned long long pr_acc = 0ull, pr_t0 = __builtin_amdgcn_s_memrealtime();
#endif
    int ph0 = args.ph_lo;
    if (ph0 == 0) {
        Ctx c; { int tid_; asm volatile("v_mbcnt_lo_u32_b32 %0, -1, 0\n\tv_mbcnt_hi_u32_b32 %0, -1, %0" : "=v"(tid_)); tid_ += wave0_ * 64;     c.lds = lds; c.tid = tid_; c.lane = c.tid & 63; c.wave = __builtin_amdgcn_readfirstlane(c.tid >> 6); c.G = gridDim.x; c.bid = blockIdx.x; }
        PSUB_T0(c, 50);
        phase_p0(c, args);
        PSUB_T1(c, 50);
        PSUB_T0(c, 51);
        if (1 < args.ph_hi) xcd_barrier(bar, t0_);
        PSUB_T1(c, 51);
        ph0 = 1;
    }
    for (int ph = ph0; ph < args.ph_hi; ++ph) {
#define MK_CTX() Ctx c; { int tid_; asm volatile("v_mbcnt_lo_u32_b32 %0, -1, 0\n\tv_mbcnt_hi_u32_b32 %0, -1, %0" : "=v"(tid_)); tid_ += wave0_ * 64;     c.lds = lds; c.tid = tid_; c.lane = c.tid & 63; c.wave = __builtin_amdgcn_readfirstlane(c.tid >> 6); c.G = gridDim.x; c.bid = blockIdx.x; }
        if (ph < 21) {
            const int l = (ph - 1) / 5, s = (ph - 1) % 5;
            if (s == 0) { MK_CTX(); phase_pa(c, args); }
            else if (s == 1) { MK_CTX(); phase_pb(c, args, l); }
            else if (s == 2) { MK_CTX(); phase_pc(c, args, l); }
            else if (s == 3) { MK_CTX(); phase_pd(c, args, l); }
            else if (s == 4) { MK_CTX(); phase_pe(c, args); }
        }
        else if (ph == 21) { MK_CTX(); phase_final(c, args); }
        if (ph + 1 < args.ph_hi) xcd_barrier(bar, t0_);
#ifdef PROBE_SEL
        { const unsigned long long t1 = __builtin_amdgcn_s_memrealtime(); if (PROBE_SEL(ph)) pr_acc += t1 - pr_t0; pr_t0 = t1; }
#endif
    }
#ifdef PROBE_SUB
    if (blockIdx.x == PROBE_BLOCK && threadIdx.x == 0) { const unsigned long long acc_ = ((volatile LAS unsigned long long*)(lds + LDS_CTL_OFF + 128))[1];
        const unsigned long long t_end = __builtin_amdgcn_s_memrealtime() + (unsigned long long)PROBE_K * acc_; while (__builtin_amdgcn_s_memrealtime() < t_end) __builtin_amdgcn_s_sleep(32); }
#endif
#ifdef PROBE_SEL
    if (blockIdx.x == 0) { const unsigned long long t_end = __builtin_amdgcn_s_memrealtime() + (unsigned long long)PROBE_K * pr_acc; while (__builtin_amdgcn_s_memrealtime() < t_end) __builtin_amdgcn_s_sleep(32); }
#endif
}

extern "C" void kernel_launch(void* const* d_in, const int* in_sizes, int n_in, void* d_out, int out_size, void* d_ws, size_t ws_size, hipStream_t stream) {
    static bool attr = false;
    if (!attr) { (void)hipFuncSetAttribute((const void*)mk, hipFuncAttributeMaxDynamicSharedMemorySize, LDS_BYTES); attr = true; }
    Args a{};
    a.x = (const float*)d_in[0]; a.norm_w = (const float*)d_in[1]; a.w_in = (const float*)d_in[2]; a.conv_w = (const float*)d_in[3]; a.conv_b = (const float*)d_in[4];
    a.gate_bias = (const float*)d_in[5]; a.ret_nw = (const float*)d_in[6]; a.ml_nw = (const float*)d_in[7]; a.w_out = (const float*)d_in[8]; a.final_nw = (const float*)d_in[9];
    a.out = (float*)d_out; a.ws = (unsigned char*)d_ws;
    unsigned char* ws = (unsigned char*)d_ws;
    (void)hipMemsetAsync(ws + WS_CTL, 0, CTL_BYTES, stream);
    const int G = 256;
    auto run = [&](int lo, int hi) { a.ph_lo = lo; a.ph_hi = hi; hipLaunchKernelGGL(mk, dim3(G), dim3(NTHREADS), LDS_BYTES, stream, a); };
    run(0, 22);
}
```

```cpp
#include <hip/hip_runtime.h>
#include <stdint.h>

#define SEQ 16384
#define DM 1024
#define DEPTH 4
#define NIN 4360
#define NP 4352
#define MIXW 1024
#define C_AQ 0
#define C_AK 512
#define C_AV 1024
#define C_AG 1536
#define C_BQ 2048
#define C_BK 2304
#define C_BV 2560
#define C_BG 2816
#define C_CQ 3072
#define C_CK 3328
#define C_CV 3584
#define C_CO 3840
#define C_CG 4096

typedef unsigned short bf16_t;
__device__ __forceinline__ float bf2f(bf16_t b) { return __uint_as_float(((unsigned)b) << 16); }
__device__ __forceinline__ bf16_t f2bf(float f) { unsigned u = __float_as_uint(f); u += 0x7FFFu + ((u >> 16) & 1u); return (bf16_t)(u >> 16); }
__device__ __forceinline__ float sigmf(float x) { return __builtin_amdgcn_rcpf(1.f + __builtin_amdgcn_exp2f(-1.4426950408889634f * x)); }
__device__ __forceinline__ float siluf(float x) { return x * sigmf(x); }

__constant__ double c_theta[32] = {1, 0.74296395075949484, 0.55199543212815705, 0.41011270705513009, 0.30469895709035083, 0.22638034095214485, 0.16819243248808699, 0.12496091412919871, 0.092841454451947455, 0.06897785379387654, 0.051248058769609341, 0.038075460212223723, 0.028288694346259694, 0.021017480113324882, 0.015615230060004972, 0.011601553017399716, 0.0086195356647530315, 0.006404004271197283, 0.0047579443140094097, 0.0035349811050301057, 0.0026263635276533325, 0.0019512934226359642, 0.0014497406703726315, 0.0010771050560367691, 0.00080025022781610535, 0.0005945570708544394, 0.00044173447031400687, 0.0003281927872511474, 0.00024383540982688293, 0.00018116091942004152, 0.00013459603241553644, 0.0001};


#define WS_CTL      0ull
#define CTL_BYTES   65536ull
#define WS_WTIN     (WS_CTL + CTL_BYTES)
#define WS_WG       (WS_WTIN + 4352ull * 1024 * 2)
#define WS_WTOUT    (WS_WG + 8ull * 1024 * 4)
#define WS_ROPE     (WS_WTOUT + 1024ull * 1024 * 2)
#define WS_SSQP     (WS_ROPE + (size_t)SEQ * 32 * 8)
#define WS_PROJ     (WS_SSQP + (size_t)SEQ * 16)
#define WS_GATES    (WS_PROJ + (size_t)SEQ * NP * 2)
#define WS_KMP      (WS_GATES + (size_t)SEQ * 32)
#define WS_KMEAN    (WS_KMP + 64ull * 2 * 512 * 4)
#define WS_XB       (WS_KMEAN + 8ull * 64 * 64 * 4)
#define WS_END0     (WS_XB + (size_t)SEQ * DM * 2)

#define CW_BAR 0

#define LDS_CTL_OFF 131072
#ifdef PROBE_SUB
#ifndef PROBE_BLOCK
#define PROBE_BLOCK 200
#endif
#define PSUB_OK(c, id) ((id) == PROBE_SUB && (c).bid == PROBE_BLOCK && threadIdx.x == 0)
#define PSUB_T0(c, id) do { if (PSUB_OK(c, id)) { *(volatile LAS unsigned long long*)((LAS unsigned char*)0 + LDS_CTL_OFF + 128) = __builtin_amdgcn_s_memrealtime(); } } while (0)
#define PSUB_T1(c, id) do { if (PSUB_OK(c, id)) { volatile LAS unsigned long long* p_ = (volatile LAS unsigned long long*)((LAS unsigned char*)0 + LDS_CTL_OFF + 128); p_[1] += __builtin_amdgcn_s_memrealtime() - p_[0]; } } while (0)
#else
#define PSUB_T0(c, id) do { } while (0)
#define PSUB_T1(c, id) do { } while (0)
#endif
typedef short bf16x8 __attribute__((ext_vector_type(8)));
typedef float f32x4 __attribute__((ext_vector_type(4)));
typedef unsigned u32x4 __attribute__((ext_vector_type(4)));
#define GAS __attribute__((address_space(1)))
#define LAS __attribute__((address_space(3)))
#define LDS_WAIT() asm volatile("s_waitcnt lgkmcnt(0)" ::: "memory")
#define VM_WAIT() asm volatile("s_waitcnt vmcnt(0)" ::: "memory")
typedef float f32x2_t __attribute__((ext_vector_type(2)));
typedef __bf16 bf16x2_t __attribute__((ext_vector_type(2)));
__device__ __forceinline__ unsigned pk2(float lo, float hi) { const f32x2_t v = {lo, hi}; const bf16x2_t b = __builtin_convertvector(v, bf16x2_t); return __builtin_bit_cast(unsigned, b); }

#define XB_TMO      128
#define XB_XCNT(j)  (256  + 64 * (j))
#define XB_XSUB(j)  (1280 + 64 * (j))
#define XB_XGEN(j)  (2304 + 64 * (j))
#define XB_TOP      3328
#define XB_TOPGEN   3392
#define XCD_BAR_WORDS 3456
#define XB_SPIN_CAP (1u << 18)
__device__ __forceinline__ unsigned xb_ld(unsigned* p)              { return __hip_atomic_load(p, __ATOMIC_RELAXED, __HIP_MEMORY_SCOPE_AGENT); }
__device__ __forceinline__ unsigned xb_add(unsigned* p, unsigned v) { return __hip_atomic_fetch_add(p, v, __ATOMIC_RELAXED, __HIP_MEMORY_SCOPE_AGENT); }
__device__ __forceinline__ unsigned xb_xcc_id() { return (unsigned)__builtin_amdgcn_s_getreg((3 << 11) | 20) & 0xFu; }
#define XB_SPIN(cond, bar) do { unsigned _sp = 0; while (cond) { __builtin_amdgcn_s_sleep(1); \
    if ((++_sp & 255u) == 0u) { if (xb_ld(&(bar)[XB_TMO])) break; if (_sp > XB_SPIN_CAP) { atomicAdd(&(bar)[XB_TMO], 1u); break; } } } } while (0)
struct XcdBarrier { unsigned* bar; unsigned x; volatile LAS unsigned* st; };
__device__ __forceinline__ XcdBarrier xcd_barrier_post(unsigned* bar, volatile LAS unsigned* st) {
    XcdBarrier b; b.bar = bar; b.x = xb_xcc_id(); b.st = st;
    if (threadIdx.x == 0) (void)xb_add(&bar[XB_XCNT(b.x)], 1u);
    return b;
}
__device__ __forceinline__ void xcd_barrier_complete(unsigned* bar, unsigned x, unsigned& nloc, unsigned& nx) {
    const unsigned G = gridDim.x * gridDim.y * gridDim.z;
    unsigned sum, cnt, mine, sp = 0u;
    for (;;) {
        sum = 0u; cnt = 0u; mine = 0u;
#pragma unroll
        for (unsigned j = 0; j < 16; ++j) { const unsigned c = xb_ld(&bar[XB_XCNT(j)]); sum += c; cnt += (c > 0u) ? 1u : 0u; mine = (j == x) ? c : mine; }
        if (sum == G) break;
        __builtin_amdgcn_s_sleep(1);
        if ((++sp & 255u) == 0u) { if (xb_ld(&bar[XB_TMO])) break; if (sp > XB_SPIN_CAP) { atomicAdd(&bar[XB_TMO], 1u); break; } }
    }
    nloc = mine > 0u ? mine : 1u; nx = cnt > 0u ? cnt : 1u;
}
__device__ __forceinline__ void xcd_barrier(const XcdBarrier& b, bool t0  ) {
    asm volatile("s_waitcnt vmcnt(0)" ::: "memory");
    __syncthreads();
    if (t0) {
        unsigned* bar = b.bar;
        __builtin_amdgcn_s_waitcnt(0);
        unsigned nloc = b.st[0], nx = b.st[1];
        if (nloc == 0u) { xcd_barrier_complete(bar, b.x, nloc, nx); b.st[0] = nloc; b.st[1] = nx; }
        const unsigned old = xb_add(&bar[XB_XSUB(b.x)], 1u);
        const unsigned gen = old / nloc;
        if (old + 1u == (gen + 1u) * nloc) {
            __builtin_amdgcn_fence(__ATOMIC_RELEASE, "agent");
            asm volatile("s_waitcnt vmcnt(0)" ::: "memory");
            const unsigned og = xb_add(&bar[XB_TOP], 1u);
            const unsigned tg = og / nx;
            if (og + 1u == (tg + 1u) * nx) xb_add(&bar[XB_TOPGEN], 1u);
            else XB_SPIN(xb_ld(&bar[XB_TOPGEN]) == tg, bar);
            __builtin_amdgcn_fence(__ATOMIC_ACQUIRE, "agent");
            xb_add(&bar[XB_XGEN(b.x)], 1u);
            asm volatile("s_waitcnt vmcnt(0)" ::: "memory");
        } else {
            XB_SPIN(xb_ld(&bar[XB_XGEN(b.x)]) == gen, bar);
            __builtin_amdgcn_fence(__ATOMIC_ACQUIRE, "agent");
            asm volatile("s_waitcnt vmcnt(0)" ::: "memory");
        }
    }
    __syncthreads();
}

namespace pg8 {
#define PG8_LAS __attribute__((address_space(3)))
constexpr int BM = 256, BK = 64, HALF = 128, HTB = HALF * BK * 2  , STAGE_BYTES = 8 * HTB, NXCD = 8, WGM = 8;
__host__ __device__ __forceinline__ int lds_byte(int r, int c) { const int st = (r >> 4) * 2 + (c >> 5), rr = r & 15, cc = c & 31, ob = rr * 64 + cc * 2; return st * 1024 + (ob ^ (((ob >> 9) & 1) << 5)); }
__host__ __device__ __forceinline__ void stage_rc(int b, int& R, int& C) { const int st = b / 1024, sb = b % 1024, swz = sb ^ (((sb >> 9) & 1) << 5); R = (st >> 1) * 16 + swz / 64; C = (st & 1) * 32 + (swz % 64) / 2; }
__host__ __device__ __forceinline__ int perm32(int rho) { const int n = rho >> 4, i = rho & 15; return 8 * (i >> 2) + 4 * n + (i & 3); }
struct Unit { int pm, pn; };
struct Gemm { const bf16_t* A; const bf16_t* Bt; int M, N, K, lda; };
template <bool YG> __device__ __forceinline__ size_t koffA(int t) {
    if (!YG) return (size_t)t * (BK * 2);
    const int col = t < 8 ? C_AG + 64 * t : (t < 12 ? C_BG + 64 * (t - 8) : C_CG + 64 * (t - 12));
    return (size_t)col * 2;
}
struct StaticOrder {
    int nM, nN, nwg, G, c;
    __host__ __device__ void init(int M, int N, int G_, int c_) { nM = M / BM; nN = N / BM; nwg = nM * nN; G = G_; c = c_; }
    __host__ __device__ bool next(int i, Unit& u) const {
        const long L = (long)i * G + c; if (L >= nwg) return false;
        int wgid = (int)L; { const int q = nwg / NXCD, r = nwg % NXCD, xcd = wgid % NXCD, off = wgid / NXCD; wgid = (xcd < r ? xcd * (q + 1) : r * (q + 1) + (xcd - r) * q) + off; }
        const int nig = WGM * nN, gid = wgid / nig, fm = gid * WGM, gsz = (nM - fm) < WGM ? (nM - fm) : WGM;
        u.pm = fm + ((wgid % nig) % gsz); u.pn = (wgid % nig) / gsz; return true;
    }
    __device__ __forceinline__ void a_ready(const Unit&) const {}
    __device__ __forceinline__ void done(const Unit&) const {}
};
__device__ __forceinline__ unsigned cvt_pk_bf16(float lo, float hi) { return pk2(lo, hi); }

struct EpiProj {
    static constexpr bool PERM = true, AFTER_DRAIN = false;
    bf16_t* proj; const float* ssqp; float* kmp; int bid;
    __device__ __forceinline__ void operator()(const f32x4 (&acc)[2][2][4][2], const Unit& u, int wr, int wc, int fr, int fq) const {
        int row0 = u.pm * BM + wr * 64 + fr, col0 = u.pn * BM + wc * 32 + 8 * fq;
        asm volatile("" : "+v"(row0), "+v"(col0));
        const bool do_km = (u.pn == 2 || u.pn == 3);
        const __amdgpu_buffer_rsrc_t prs = __builtin_amdgcn_make_buffer_rsrc((void*)proj, 0, 0x7fffffff, 0x00020000);
        f32x4 cs[2][2];
#pragma unroll
        for (int bj = 0; bj < 2; ++bj)
#pragma unroll
            for (int n = 0; n < 2; ++n) cs[bj][n] = (f32x4){0.f, 0.f, 0.f, 0.f};
#pragma unroll
        for (int ai = 0; ai < 2; ++ai)
#pragma unroll
            for (int m = 0; m < 4; ++m) {
                const int r = row0 + ai * HALF + m * 16;
                const f32x4 s4 = *(const f32x4*)(ssqp + (size_t)r * 4);
                const float rs = rsqrtf(((s4[0] + s4[1]) + (s4[2] + s4[3])) * (1.0f / 1024.0f) + 1e-6f);
                const unsigned rowoff = (unsigned)((r * NP + col0) * 2);
#pragma unroll
                for (int bj = 0; bj < 2; ++bj) {
                    const f32x4 v0 = acc[ai][bj][m][0] * rs, v1 = acc[ai][bj][m][1] * rs;
                    u32x4 w; w.x = cvt_pk_bf16(v0[0], v0[1]); w.y = cvt_pk_bf16(v0[2], v0[3]); w.z = cvt_pk_bf16(v1[0], v1[1]); w.w = cvt_pk_bf16(v1[2], v1[3]);
                    __builtin_amdgcn_raw_buffer_store_b128(w, prs, rowoff + bj * HALF * 2, 0, 16);
                    cs[bj][0] += v0; cs[bj][1] += v1;
                }
            }
        if (do_km) {
#pragma unroll
            for (int bj = 0; bj < 2; ++bj)
#pragma unroll
                for (int n = 0; n < 2; ++n)
#pragma unroll
                    for (int i = 0; i < 4; ++i) {
                        float v = cs[bj][n][i];
                        v += __shfl_xor(v, 1); v += __shfl_xor(v, 2); v += __shfl_xor(v, 4); v += __shfl_xor(v, 8);
                        cs[bj][n][i] = v;
                    }
            if (fr == 0) {
                float* kp = kmp + (size_t)(u.pm * 2 + wr) * 512 + (col0 - C_AK);
#pragma unroll
                for (int bj = 0; bj < 2; ++bj) { *(f32x4*)(kp + bj * HALF) = cs[bj][0]; *(f32x4*)(kp + bj * HALF + 4) = cs[bj][1]; }
            }
        }
    }
};

struct EpiOut {
    static constexpr bool PERM = true, AFTER_DRAIN = true;
    bf16_t* xb; float* ssqp; int bid;
    __device__ __forceinline__ void fused(f32x4 (&acc)[2][2][4][2], const Unit& u, int wr, int wc, int fr, int fq, PG8_LAS unsigned char* lds, int wid, int lane) const {
        PG8_LAS float* P = (PG8_LAS float*)lds;
        int row0 = wr * 64 + fr, col0 = u.pn * BM + wc * 32 + 8 * fq;
        asm volatile("" : "+v"(row0), "+v"(col0));
        const __amdgpu_buffer_rsrc_t xrs = __builtin_amdgcn_make_buffer_rsrc((void*)xb, 0, 0x7fffffff, 0x00020000);
#pragma unroll
        for (int ai = 0; ai < 2; ++ai)
#pragma unroll
            for (int m = 0; m < 4; ++m) {
                const int rl = row0 + ai * HALF + m * 16; const unsigned off = (unsigned)((u.pm * BM + rl) * DM + col0);
                u32x4 xo[2];
#pragma unroll
                for (int bj = 0; bj < 2; ++bj) xo[bj] = *(const u32x4*)(xb + off + bj * HALF);
                float ss = 0.f;
#pragma unroll
                for (int bj = 0; bj < 2; ++bj) {
                    const u32x4 w0 = xo[bj];
                    f32x4 x0 = acc[ai][bj][m][0], x1 = acc[ai][bj][m][1];
                    x0[0] += __uint_as_float(w0.x << 16); x0[1] += __uint_as_float(w0.x & 0xffff0000u); x0[2] += __uint_as_float(w0.y << 16); x0[3] += __uint_as_float(w0.y & 0xffff0000u);
                    x1[0] += __uint_as_float(w0.z << 16); x1[1] += __uint_as_float(w0.z & 0xffff0000u); x1[2] += __uint_as_float(w0.w << 16); x1[3] += __uint_as_float(w0.w & 0xffff0000u);
                    u32x4 w; w.x = cvt_pk_bf16(x0[0], x0[1]); w.y = cvt_pk_bf16(x0[2], x0[3]); w.z = cvt_pk_bf16(x1[0], x1[1]); w.w = cvt_pk_bf16(x1[2], x1[3]);
                    __builtin_amdgcn_raw_buffer_store_b128(w, xrs, (off + bj * HALF) * 2, 0, 16);
                    ss += ((x0[0] * x0[0] + x0[1] * x0[1]) + (x0[2] * x0[2] + x0[3] * x0[3])) + ((x1[0] * x1[0] + x1[1] * x1[1]) + (x1[2] * x1[2] + x1[3] * x1[3]));
                }
                ss += __shfl_xor(ss, 16); ss += __shfl_xor(ss, 32);
                if (fq == 0) P[rl * 4 + wc] = ss;
            }
        asm volatile("s_waitcnt lgkmcnt(0)" ::: "memory"); __builtin_amdgcn_s_barrier(); asm volatile("" ::: "memory");
        const int t = wid * 64 + lane;
        if (t < 256) { const f32x4 p = *(const PG8_LAS f32x4*)(P + t * 4); __hip_atomic_store(ssqp + (size_t)(u.pm * BM + t) * 4 + u.pn, (p[0] + p[1]) + (p[2] + p[3]), __ATOMIC_RELAXED, __HIP_MEMORY_SCOPE_AGENT); }
        asm volatile("s_waitcnt lgkmcnt(0)" ::: "memory"); __builtin_amdgcn_s_barrier(); asm volatile("" ::: "memory");
    }
};
template <class Epi, class Sched, bool YG>
__device__ __forceinline__ void gemm_phase(PG8_LAS unsigned char* lds, const Gemm g, const Sched& S, const Epi& E, int tid_in) {
    int tid_ = tid_in; asm volatile("" : "+v"(tid_));
    const int tid = tid_, wid = __builtin_amdgcn_readfirstlane(tid >> 6), lane = tid & 63, wr = wid >> 2, wc = wid & 3, fr = lane & 15, fq = lane >> 4;
    const int K = g.K, nt = K / BK;
    unsigned voffA[2], voffB[2];
#pragma unroll
    for (int i = 0; i < 2; ++i) { int R, C; stage_rc(tid * 16 + i * 8192, R, C); const int Rb = Epi::PERM ? ((R & ~31) + perm32(R & 31)) : R;
        voffA[i] = (unsigned)(R * g.lda + C) * 2u; voffB[i] = (unsigned)(Rb * K + C) * 2u; }
    const size_t kstep = (size_t)(BK * 2);
    const size_t hstep = (size_t)HALF * K * 2;
    const size_t tstep = 2 * hstep;
    const size_t hstepA = (size_t)HALF * g.lda * 2, tstepA = 2 * hstepA;
    const unsigned ldsw = (unsigned)wid * 1024u;
    const int aoff = lds_byte(wr * 64 + fr, fq * 8), boff = lds_byte(wc * 32 + fr, fq * 8);
#define PG8_SA(b, h) (((b) * 2 + (h)) * HTB)
#define PG8_SB(b, h) ((4 + (b) * 2 + (h)) * HTB)
#define PG8_STAGE(bufoff, gbase, voff) do { _Pragma("unroll") for (int _i = 0; _i < 2; ++_i) \
        __builtin_amdgcn_global_load_lds((const unsigned*)((const char*)(gbase) + (voff)[_i]), (PG8_LAS unsigned*)(lds + (bufoff) + ldsw + _i * 8192), 16, 0, 0); } while (0)
#define PG8_LDA(dst, b, h) do { _Pragma("unroll") for (int m = 0; m < 4; ++m) _Pragma("unroll") for (int k = 0; k < 2; ++k) dst[m][k] = *(const PG8_LAS bf16x8*)(lds + PG8_SA(b, h) + aoff + m * 2048 + k * 1024); } while (0)
#define PG8_LDB(dst, b, h) do { _Pragma("unroll") for (int n = 0; n < 2; ++n) _Pragma("unroll") for (int k = 0; k < 2; ++k) dst[n][k] = *(const PG8_LAS bf16x8*)(lds + PG8_SB(b, h) + boff + n * 2048 + k * 1024); } while (0)
#define PG8_MMA(ai, bj, At, Bt) do { __builtin_amdgcn_s_setprio(1); _Pragma("unroll") for (int m = 0; m < 4; ++m) _Pragma("unroll") for (int n = 0; n < 2; ++n) _Pragma("unroll") for (int k = 0; k < 2; ++k) \
        acc[ai][bj][m][n] = __builtin_amdgcn_mfma_f32_16x16x32_bf16(Bt[n][k], At[m][k], acc[ai][bj][m][n], 0, 0, 0); __builtin_amdgcn_s_setprio(0); } while (0)
#define PG8_WAIT_V(n) asm volatile("s_waitcnt vmcnt(" #n ")" ::: "memory")
#define PG8_WAIT_L(n) asm volatile("s_waitcnt lgkmcnt(" #n ")" ::: "memory")
#define PG8_BAR __builtin_amdgcn_s_barrier()
#define PG8_SCHED __builtin_amdgcn_sched_barrier(0)
    Unit cur, nxt; int ui = 0;
    if (!S.next(0, cur)) return;
    f32x4 acc[2][2][4][2];
#pragma unroll
    for (int a = 0; a < 2; ++a)
#pragma unroll
        for (int b = 0; b < 2; ++b)
#pragma unroll
            for (int m = 0; m < 4; ++m)
#pragma unroll
                for (int n = 0; n < 2; ++n) acc[a][b][m][n] = (f32x4){0.f, 0.f, 0.f, 0.f};
    bf16x8 At[4][2], B0[2][2], B1[2][2];
    const char* cA = (const char*)g.A + (size_t)cur.pm * tstepA; const char* cB = (const char*)g.Bt + (size_t)cur.pn * tstep;
    S.a_ready(cur);
    PG8_STAGE(PG8_SB(0, 0), cB, voffB); PG8_STAGE(PG8_SA(0, 0), cA + koffA<YG>(0), voffA); PG8_STAGE(PG8_SB(0, 1), cB + hstep, voffB); PG8_STAGE(PG8_SA(0, 1), cA + koffA<YG>(0) + hstepA, voffA);
    if (wr == 1) PG8_BAR;
    PG8_WAIT_V(4); PG8_BAR;
    PG8_STAGE(PG8_SB(1, 0), cB + kstep, voffB); PG8_STAGE(PG8_SA(1, 0), cA + koffA<YG>(1), voffA); PG8_STAGE(PG8_SB(1, 1), cB + hstep + kstep, voffB);
    PG8_WAIT_V(6); PG8_BAR;
    for (;;) {
        const bool has_next = S.next(ui + 1, nxt);
        const char* nA = has_next ? (const char*)g.A + (size_t)nxt.pm * tstepA : cA; const char* nB = has_next ? (const char*)g.Bt + (size_t)nxt.pn * tstep : cB;
        PSUB_T0(E, 42);
        for (int t = 0; t < nt; t += 2) {
            const bool last = (t == nt - 2);
            const char* a1 = cA + koffA<YG>(t + 1);
            const char* a2 = last ? nA + koffA<YG>(0) : cA + koffA<YG>(t + 2); const char* b2 = last ? nB : cB + (size_t)(t + 2) * kstep;
            const char* a3 = last ? nA + koffA<YG>(1) : cA + koffA<YG>(t + 3); const char* b3 = b2 + kstep;
            if (last && has_next) S.a_ready(nxt);
            PG8_LDB(B0, 0, 0); PG8_SCHED; PG8_LDA(At, 0, 0); PG8_STAGE(PG8_SA(1, 1), a1 + hstepA, voffA);
            PG8_WAIT_L(8); PG8_BAR; PG8_WAIT_L(0); PG8_MMA(0, 0, At, B0); PG8_BAR; PG8_SCHED;
            PG8_LDB(B1, 0, 1); PG8_STAGE(PG8_SB(0, 0), b2, voffB);
            PG8_BAR; PG8_WAIT_L(0); PG8_MMA(0, 1, At, B1); PG8_BAR;
            PG8_LDA(At, 0, 1); PG8_STAGE(PG8_SA(0, 0), a2, voffA);
            PG8_BAR; PG8_WAIT_L(0); PG8_MMA(1, 0, At, B0); PG8_BAR; PG8_SCHED;
            PG8_STAGE(PG8_SB(0, 1), b2 + hstep, voffB);
            PG8_WAIT_V(6); PG8_BAR; PG8_MMA(1, 1, At, B1); PG8_BAR;
            PG8_LDB(B0, 1, 0); PG8_SCHED; PG8_LDA(At, 1, 0); PG8_STAGE(PG8_SA(0, 1), a2 + hstepA, voffA);
            PG8_WAIT_L(8); PG8_BAR; PG8_WAIT_L(0); PG8_MMA(0, 0, At, B0); PG8_BAR; PG8_SCHED;
            PG8_LDB(B1, 1, 1); PG8_STAGE(PG8_SB(1, 0), b3, voffB);
            PG8_BAR; PG8_WAIT_L(0); PG8_MMA(0, 1, At, B1); PG8_BAR;
            PG8_LDA(At, 1, 1); PG8_STAGE(PG8_SA(1, 0), a3, voffA);
            PG8_BAR; PG8_WAIT_L(0); PG8_MMA(1, 0, At, B0); PG8_BAR; PG8_SCHED;
            PG8_STAGE(PG8_SB(1, 1), b3 + hstep, voffB);
            PG8_WAIT_V(6); PG8_BAR; PG8_MMA(1, 1, At, B1); PG8_BAR;
        }
        PSUB_T1(E, 42);
        if constexpr (!Epi::AFTER_DRAIN) { PSUB_T0(E, 40); E(acc, cur, wr, wc, fr, fq); S.done(cur); PSUB_T1(E, 40); }
        if (!has_next) break;
#pragma unroll
        for (int a = 0; a < 2; ++a)
#pragma unroll
            for (int b = 0; b < 2; ++b)
#pragma unroll
                for (int m = 0; m < 4; ++m)
#pragma unroll
                    for (int n = 0; n < 2; ++n) acc[a][b][m][n] = (f32x4){0.f, 0.f, 0.f, 0.f};
        cur = nxt; cA = nA; cB = nB; ++ui;
    }
    PG8_WAIT_V(0);
    if (wr == 0) PG8_BAR;
    PG8_BAR;
    if constexpr (Epi::AFTER_DRAIN) { E.fused(acc, cur, wr, wc, fr, fq, lds, wid, lane); S.done(cur); }
#undef PG8_SA
#undef PG8_SB
#undef PG8_STAGE
#undef PG8_LDA
#undef PG8_LDB
#undef PG8_MMA
#undef PG8_WAIT_V
#undef PG8_WAIT_L
#undef PG8_BAR
#undef PG8_SCHED
}

}

#define NTHREADS 512
#define LDS_BYTES 147456

struct Args {
    const float *x, *norm_w, *w_in, *conv_w, *conv_b, *gate_bias, *ret_nw, *ml_nw, *w_out, *final_nw;
    float* out; unsigned char* ws; int ph_lo, ph_hi;
};

struct Ctx {
    LAS unsigned char* lds;
    int tid, lane, wave, G, bid;
};

#define GT 256
#define LDS_GRP_SCR(g) (LDS_CTL_OFF + 1024 + (g) * 6144)
#define LDS_PRE (LDS_CTL_OFF + 1024 + 2 * 6144)
struct GCtx {
    LAS unsigned char* lds;
    LAS unsigned char* scr;
    volatile LAS unsigned* bctr;
    unsigned gen;
    int tid, lane, wave, grp;
    int gg, ng, bid;
};
__device__ __forceinline__ void gsync(GCtx& c) {
    asm volatile("s_waitcnt lgkmcnt(0)" ::: "memory");
    if (c.lane == 0) __hip_atomic_fetch_add((LAS unsigned*)c.bctr, 1u, __ATOMIC_RELAXED, __HIP_MEMORY_SCOPE_WORKGROUP);
    c.gen += 4u;
    while ((unsigned)__builtin_amdgcn_readfirstlane((int)__hip_atomic_load((LAS unsigned*)c.bctr, __ATOMIC_RELAXED, __HIP_MEMORY_SCOPE_WORKGROUP)) < c.gen) __builtin_amdgcn_s_sleep(0);
    asm volatile("" ::: "memory");
}
#define UNIT_FENCE(g) do { asm volatile("" : "+v"((g).tid)); (g).lane = (g).tid & 63; } while (0)
__device__ __forceinline__ GCtx make_group(const Ctx& c) {
    GCtx g; g.grp = c.wave >> 2; g.wave = c.wave & 3; g.tid = c.tid & 255; g.lane = c.lane;
    g.lds = c.lds + g.grp * 65536; g.scr = c.lds + LDS_GRP_SCR(g.grp);
    g.bctr = (volatile LAS unsigned*)(c.lds + LDS_CTL_OFF + 96) + g.grp;
    g.gen = *g.bctr;
    g.gg = c.bid * 2 + g.grp; g.ng = c.G * 2; g.bid = c.bid;
    __syncthreads();
    return g;
}

__device__ __forceinline__ void transpose_item(const float* W, int K, int Nsrc, int nblk, bf16_t* WT, const float* sc, LAS float* scr, int item, int lane) {
    const int kb = item / nblk, nb = item % nblk, k0 = 64 * kb, n0 = 32 * nb;
    {
        f32x4 v[8]; float s8[8];
#pragma unroll
        for (int i = 0; i < 8; ++i) { const int kk = 8 * i + (lane >> 3); v[i] = *(const f32x4*)(W + (size_t)(k0 + kk) * Nsrc + n0 + 4 * (lane & 7)); s8[i] = sc ? sc[k0 + kk] : 1.f; }
#pragma unroll
        for (int i = 0; i < 8; ++i) { const int kk = 8 * i + (lane >> 3); LAS float* d = scr + kk * 33 + 4 * (lane & 7);
            d[0] = v[i][0] * s8[i]; d[1] = v[i][1] * s8[i]; d[2] = v[i][2] * s8[i]; d[3] = v[i][3] * s8[i]; }
    }
    LDS_WAIT(); asm volatile("" ::: "memory");
    const int c = lane & 7;
#pragma unroll
    for (int j = 0; j < 4; ++j) { const int n = (lane >> 3) + 8 * j; const LAS float* s = scr + (8 * c) * 33 + n;
        u32x4 o; o.x = pk2(s[0 * 33], s[1 * 33]); o.y = pk2(s[2 * 33], s[3 * 33]); o.z = pk2(s[4 * 33], s[5 * 33]); o.w = pk2(s[6 * 33], s[7 * 33]);
        *(u32x4*)(WT + (size_t)(n0 + n) * K + k0 + 8 * c) = o; }
    LDS_WAIT(); asm volatile("" ::: "memory");
}

__device__ __forceinline__ void convert_w_in(const Ctx& c, const Args& a, int l) {
    LAS float* scr = (LAS float*)(c.lds + c.wave * 16384);
    const int gw = c.bid * 8 + c.wave, NGW = c.G * 8;
    const float* W = a.w_in + (size_t)l * DM * NIN; const float* nw = a.norm_w + (size_t)l * DM;
    bf16_t* WT = (bf16_t*)(a.ws + WS_WTIN);
    constexpr int NBLK = NP / 32, NITEMS = (DM / 64) * NBLK;
    for (int it = gw; it < NITEMS; it += NGW) transpose_item(W, DM, NIN, NBLK, WT, nw, scr, it, c.lane);
    bf16_t* WG = (bf16_t*)(a.ws + WS_WG);
    for (int i = c.bid * NTHREADS + c.tid; i < 8 * DM; i += c.G * NTHREADS) { const int j = i >> 10, k = i & 1023; WG[i] = f2bf(W[(size_t)k * NIN + NP + j] * nw[k]); }
}
__device__ __forceinline__ void convert_w_out(const Ctx& c, const Args& a, int l, int rot = 0) {
    LAS float* scr = (LAS float*)(c.lds + c.wave * 16384);
    const int NGW = c.G * 8, gw = (c.bid * 8 + c.wave + rot) % NGW;
    const float* W = a.w_out + (size_t)l * MIXW * DM;
    bf16_t* WT = (bf16_t*)(a.ws + WS_WTOUT);
    constexpr int NBLK = DM / 32, NITEMS = (MIXW / 64) * NBLK;
    for (int it = gw; it < NITEMS; it += NGW) transpose_item(W, MIXW, DM, NBLK, WT, nullptr, scr, it, c.lane);
}

__device__ __forceinline__ void rope_entry(float2* tab, int i) {
    int pos = i >> 5, f = i & 31;
    double a = (double)pos * c_theta[f];
    double k = rint(a * 0.63661977236758134308);
    double r = a - k * 1.57079632679489661923;
    r -= k * 6.123233995736766e-17;
    double r2 = r * r;
    double s = r * (1.0 + r2 * (-1.0 / 6 + r2 * (1.0 / 120 + r2 * (-1.0 / 5040 + r2 * (1.0 / 362880 + r2 * (-1.0 / 39916800 + r2 * (1.0 / 6227020800.0)))))));
    double cc = 1.0 + r2 * (-0.5 + r2 * (1.0 / 24 + r2 * (-1.0 / 720 + r2 * (1.0 / 40320 + r2 * (-1.0 / 3628800 + r2 * (1.0 / 479001600.0 + r2 * (-1.0 / 87178291200.0)))))));
    long long kq = (long long)k; int q = (int)(kq & 3);
    double cs, sn;
    if (q == 0) { cs = cc; sn = s; } else if (q == 1) { cs = -s; sn = cc; } else if (q == 2) { cs = -cc; sn = -s; } else { cs = s; sn = -cc; }
    tab[i] = make_float2((float)cs, (float)sn);
}

__device__ __forceinline__ void xprep_row(const float* xrow, float* orow, bf16_t* brow, float* ssq4, int lane) {
    const f32x4* xr = (const f32x4*)xrow + lane;
    f32x4 v[4]; float s = 0.f;
#pragma unroll
    for (int j = 0; j < 4; ++j) { v[j] = xr[64 * j]; s += (v[j][0] * v[j][0] + v[j][1] * v[j][1]) + (v[j][2] * v[j][2] + v[j][3] * v[j][3]); }
#pragma unroll
    for (int o = 1; o < 64; o <<= 1) s += __shfl_xor(s, o);
    if (orow) {
#pragma unroll
        for (int j = 0; j < 4; ++j) ((f32x4*)orow + lane)[64 * j] = v[j];
    }
    unsigned long long* o8 = (unsigned long long*)brow + lane;
#pragma unroll
    for (int j = 0; j < 4; ++j) o8[64 * j] = (unsigned long long)pk2(v[j][0], v[j][1]) | ((unsigned long long)pk2(v[j][2], v[j][3]) << 32);
    if (lane == 0) *(f32x4*)ssq4 = (f32x4){s, 0.f, 0.f, 0.f};
}

__device__ __forceinline__ void phase_p0(const Ctx& c, const Args& a) {
    convert_w_in(c, a, 0);
    convert_w_out(c, a, 0, c.G * 8 - 128);
    float2* rope = (float2*)(a.ws + WS_ROPE);
    for (int i = c.bid * NTHREADS + c.tid; i < SEQ * 32; i += c.G * NTHREADS) rope_entry(rope, i);
    const int gw = c.bid * 8 + c.wave, NGW = c.G * 8;
    bf16_t* xb = (bf16_t*)(a.ws + WS_XB); float* ssqp = (float*)(a.ws + WS_SSQP);
    for (int m = gw; m < SEQ; m += 2 * NGW) {
        f32x4 v[2][4]; float s[2];
#pragma unroll
        for (int r = 0; r < 2; ++r) { const f32x4* xr = (const f32x4*)(a.x + (size_t)(m + r * NGW) * DM) + c.lane;
#pragma unroll
            for (int j = 0; j < 4; ++j) v[r][j] = xr[64 * j]; }
#pragma unroll
        for (int r = 0; r < 2; ++r) { float q = 0.f;
#pragma unroll
            for (int j = 0; j < 4; ++j) q += (v[r][j][0] * v[r][j][0] + v[r][j][1] * v[r][j][1]) + (v[r][j][2] * v[r][j][2] + v[r][j][3] * v[r][j][3]);
#pragma unroll
            for (int o = 1; o < 64; o <<= 1) q += __shfl_xor(q, o);
            s[r] = q; }
#pragma unroll
        for (int r = 0; r < 2; ++r) { const int row = m + r * NGW;
            unsigned long long* o8 = (unsigned long long*)(xb + (size_t)row * DM) + c.lane;
#pragma unroll
            for (int j = 0; j < 4; ++j) o8[64 * j] = (unsigned long long)pk2(v[r][j][0], v[r][j][1]) | ((unsigned long long)pk2(v[r][j][2], v[r][j][3]) << 32);
            if (c.lane == 0) *(f32x4*)(ssqp + (size_t)row * 4) = (f32x4){s[r], 0.f, 0.f, 0.f}; }
    }
}

__device__ __forceinline__ void gates_rows(const Ctx& c, const Args& a, int rb0) {
    const bf16_t* xb = (const bf16_t*)(a.ws + WS_XB); const bf16_t* WG = (const bf16_t*)(a.ws + WS_WG);
    const float* ssqp = (const float*)(a.ws + WS_SSQP); float* gates = (float*)(a.ws + WS_GATES);
    LAS f32x4* red = (LAS f32x4*)c.lds;
    const int i = c.lane & 15, g = c.lane >> 4, rt = c.wave & 3, kh = c.wave >> 2;
    for (int rb = rb0; rb < SEQ / 64; rb += SEQ / 64) {
        const bf16_t* ap = xb + (size_t)(rb * 64 + rt * 16 + i) * DM + kh * 512 + 8 * g;
        const bf16_t* bp = WG + (size_t)(i & 7) * DM + kh * 512 + 8 * g;
        f32x4 acc = (f32x4){0.f, 0.f, 0.f, 0.f};
        f32x4 sq[4];
#pragma unroll
        for (int r = 0; r < 4; ++r) sq[r] = *(const f32x4*)(ssqp + (size_t)(rb * 64 + rt * 16 + 4 * g + r) * 4);
        {
            bf16x8 af[16], bf[16];
#pragma unroll
            for (int s = 0; s < 16; ++s) { af[s] = *(const bf16x8*)(ap + s * 32); bf[s] = *(const bf16x8*)(bp + s * 32); }
#pragma unroll
            for (int s = 0; s < 16; ++s) { const bf16x8 b = i < 8 ? bf[s] : (bf16x8){0, 0, 0, 0, 0, 0, 0, 0}; acc = __builtin_amdgcn_mfma_f32_16x16x32_bf16(af[s], b, acc, 0, 0, 0); }
        }
        if (kh == 1) red[rt * 64 + c.lane] = acc;
        __syncthreads();
        if (kh == 0) {
            acc += red[rt * 64 + c.lane];
            if (i < 8) {
#pragma unroll
                for (int r = 0; r < 4; ++r) {
                    const int row = rb * 64 + rt * 16 + 4 * g + r;
                    const f32x4 s4 = sq[r];
                    const float rs = rsqrtf(((s4[0] + s4[1]) + (s4[2] + s4[3])) * (1.0f / 1024.0f) + 1e-6f);
                    gates[(size_t)row * 8 + i] = acc[r] * rs;
                }
            }
        }
        __syncthreads();
    }
}

#define CW_RDY(l, pm) (8192 + (l) * 1024 + (pm) * 16)
__device__ __forceinline__ int panel_of(int bid) { return 8 * (bid & 7) + ((bid >> 3) & 7); }
__device__ __forceinline__ void phase_pa(const Ctx& c, const Args& a, int l) {
    PSUB_T0(c, 43);
    const int pm = panel_of(c.bid);
    if (l >= 1) {
        if (c.wave == 0) {
            unsigned* rdy = (unsigned*)(a.ws + WS_CTL) + CW_RDY(l - 1, pm);
            unsigned spins = 0;
            while ((unsigned)__builtin_amdgcn_readfirstlane((int)__hip_atomic_load(rdy, __ATOMIC_RELAXED, __HIP_MEMORY_SCOPE_AGENT)) < 4u) { __builtin_amdgcn_s_sleep(2); if (++spins > (1u << 22)) break; }
            __builtin_amdgcn_fence(__ATOMIC_ACQUIRE, "agent");
            asm volatile("s_waitcnt vmcnt(0)" ::: "memory");
        }
        __syncthreads();
    }
    PSUB_T0(c, 41); gates_rows(c, a, pm * 4 + (c.bid >> 6)); PSUB_T1(c, 41);
    pg8::Gemm g{(const bf16_t*)(a.ws + WS_XB), (const bf16_t*)(a.ws + WS_WTIN), SEQ, 4096, DM, DM};
    pg8::StaticOrder S; S.init(SEQ, 4096, c.G, c.bid);
    pg8::EpiProj E{(bf16_t*)(a.ws + WS_PROJ), (const float*)(a.ws + WS_SSQP), (float*)(a.ws + WS_KMP), c.bid};
    pg8::gemm_phase<pg8::EpiProj, pg8::StaticOrder, false>(c.lds, g, S, E, c.tid);
    PSUB_T1(c, 43);
}
struct TailOrder {
    int pm;
    __device__ __forceinline__ bool next(int i, pg8::Unit& u) const { if (i > 0) return false; u.pm = pm; u.pn = 16; return true; }
    __device__ __forceinline__ void a_ready(const pg8::Unit&) const {}
    __device__ __forceinline__ void done(const pg8::Unit&) const {}
};
#define N_TAIL_WG 64
__device__ __forceinline__ void gemm_tail(const Ctx& c, const Args& a) {
    pg8::Gemm g{(const bf16_t*)(a.ws + WS_XB), (const bf16_t*)(a.ws + WS_WTIN), SEQ, NP, DM, DM};
    TailOrder S; S.pm = c.bid;
    pg8::EpiProj E{(bf16_t*)(a.ws + WS_PROJ), (const float*)(a.ws + WS_SSQP), (float*)(a.ws + WS_KMP), c.bid};
    pg8::gemm_phase<pg8::EpiProj, TailOrder, false>(c.lds, g, S, E, c.tid);
}
__device__ __forceinline__ void phase_pe(const Ctx& c, const Args& a, int l) {
    pg8::Gemm g{(const bf16_t*)(a.ws + WS_PROJ), (const bf16_t*)(a.ws + WS_WTOUT), SEQ, DM, MIXW, NP};
    pg8::StaticOrder S; S.init(SEQ, DM, c.G, c.bid);
    pg8::EpiOut E{(bf16_t*)(a.ws + WS_XB), (float*)(a.ws + WS_SSQP), c.bid};
    pg8::gemm_phase<pg8::EpiOut, pg8::StaticOrder, true>(c.lds, g, S, E, c.tid);
    if (l + 1 < DEPTH) {
        asm volatile("s_waitcnt vmcnt(0)" ::: "memory");
        __syncthreads();
        if (c.tid == 0) {
            __hip_atomic_fetch_add((unsigned*)(a.ws + WS_CTL) + CW_RDY(l, panel_of(c.bid)), 1u, __ATOMIC_RELAXED, __HIP_MEMORY_SCOPE_AGENT);
        }
    }
}
__device__ __forceinline__ void phase_final(const Ctx& c, const Args& a) {
    const int gw = c.bid * 8 + c.wave, NGW = c.G * 8;
    const float* ssqp = (const float*)(a.ws + WS_SSQP); const bf16_t* xb = (const bf16_t*)(a.ws + WS_XB);
    f32x4 w[4];
#pragma unroll
    for (int j = 0; j < 4; ++j) w[j] = ((const f32x4*)a.final_nw + c.lane)[64 * j];
    for (int m = gw; m < SEQ; m += 2 * NGW) {
        uint2 xv[2][4]; f32x4 s4[2];
#pragma unroll
        for (int r = 0; r < 2; ++r) { const int row = m + r * NGW; s4[r] = *(const f32x4*)(ssqp + (size_t)row * 4);
#pragma unroll
            for (int j = 0; j < 4; ++j) xv[r][j] = ((const uint2*)(xb + (size_t)row * DM) + c.lane)[64 * j]; }
#pragma unroll
        for (int r = 0; r < 2; ++r) { const int row = m + r * NGW;
            const float rs = rsqrtf(((s4[r][0] + s4[r][1]) + (s4[r][2] + s4[r][3])) * (1.0f / 1024.0f) + 1e-6f);
            f32x4* xr = (f32x4*)(a.out + (size_t)row * DM) + c.lane;
#pragma unroll
            for (int j = 0; j < 4; ++j) { const uint2 q = xv[r][j];
                f32x4 v; v[0] = __uint_as_float(q.x << 16); v[1] = __uint_as_float(q.x & 0xffff0000u); v[2] = __uint_as_float(q.y << 16); v[3] = __uint_as_float(q.y & 0xffff0000u);
                xr[64 * j] = v * rs * w[j]; } }
    }
}

#define WS_RPREV  WS_END0
#define WS_CPREV  (WS_RPREV + 4ull * 64 * 4096 * 2)
#define WS_NPREV  (WS_CPREV + 4ull * 128 * 4096 * 2)
#define WS_MPREV  (WS_NPREV + 4ull * 128 * 64 * 4)
#define WS_PART   (WS_MPREV + 4096ull)
#define WS_PML    (WS_PART + (size_t)SEQ * 8 * 3 * 64 * 2)
#define WS_END1   (WS_PML + (size_t)SEQ * 8 * 3 * 8)
#define LIST_PER_HEAD 516096
#define WS_LIST   WS_END1
#define WS_KVRET  (WS_LIST + 8ull * LIST_PER_HEAD * 4)
#define WS_KVML   (WS_KVRET + 4ull * 64 * 4096 * 4)
#define WS_NLOC   (WS_KVML + 4ull * 128 * 4096 * 4)
#define WS_MLOC   (WS_NLOC + 4ull * 128 * 64 * 4)
#define WS_BC     (WS_MLOC + 4ull * 128 * 4)
#define WS_END2   (WS_BC + 4ull * 128 * 4)

typedef short s16x4 __attribute__((ext_vector_type(4)));
#define TILE_OFF(row, c16) ((row) * 128 + (((((c16) >> 1) ^ (((row) >> 1) & 3))) << 5) + (((c16) & 1) << 4))
#define MFMA16(a, b, c) __builtin_amdgcn_mfma_f32_16x16x32_bf16(a, b, c, 0, 0, 0)
#define LDS_KT 0
#define LDS_VT 32768

__device__ __forceinline__ void unpack8(const u32x4 x, float (&v)[8]) {
    v[0] = __uint_as_float(x.x << 16); v[1] = __uint_as_float(x.x & 0xffff0000u); v[2] = __uint_as_float(x.y << 16); v[3] = __uint_as_float(x.y & 0xffff0000u);
    v[4] = __uint_as_float(x.z << 16); v[5] = __uint_as_float(x.z & 0xffff0000u); v[6] = __uint_as_float(x.w << 16); v[7] = __uint_as_float(x.w & 0xffff0000u);
}
__device__ __forceinline__ u32x4 pack8(const float (&v)[8]) { u32x4 w; w.x = pk2(v[0], v[1]); w.y = pk2(v[2], v[3]); w.z = pk2(v[4], v[5]); w.w = pk2(v[6], v[7]); return w; }
__device__ __forceinline__ void tile_store8(LAS unsigned char* tile, int row, int c16, const float (&v)[8]) { *(LAS u32x4*)(tile + TILE_OFF(row, c16)) = pack8(v); }
__device__ __forceinline__ bf16x8 tile_rowfrag(LAS unsigned char* tile, int row, int c16) { return *(const LAS bf16x8*)(tile + TILE_OFF(row, c16)); }
typedef short v4i16_t __attribute__((ext_vector_type(4)));
__device__ __forceinline__ s16x4 lds_tr(LAS unsigned char* p) { return __builtin_bit_cast(s16x4, __builtin_amdgcn_ds_read_tr16_b64_v4i16((LAS v4i16_t*)p)); }
__device__ __forceinline__ bf16x8 tile_trfrag(LAS unsigned char* tile, int key0, int et, int lane) {
    const int i = lane & 15, g = lane >> 4, r1 = key0 + 4 * g + (i >> 2);
    LAS unsigned char* p = tile + r1 * 128 + ((et ^ ((r1 >> 1) & 3)) << 5) + (i & 3) * 8;
    const s16x4 a = lds_tr(p), b = lds_tr(p + 2048);
    return (bf16x8){a[0], a[1], a[2], a[3], b[0], b[1], b[2], b[3]};
}
__device__ __forceinline__ f32x4 st_tile(LAS unsigned char* Kt, int krow0, const bf16x8 (&qf)[2], int lane) {
    const int key = krow0 + (lane & 15), g = lane >> 4;
    f32x4 acc = (f32x4){0.f, 0.f, 0.f, 0.f};
    acc = MFMA16(tile_rowfrag(Kt, key, g), qf[0], acc);
    acc = MFMA16(tile_rowfrag(Kt, key, 4 + g), qf[1], acc);
    return acc;
}
__device__ __forceinline__ void pv_step(LAS unsigned char* Vt, int key0, const f32x4& s0, const f32x4& s1, f32x4 (&O)[4], int lane) {
    u32x4 pw; pw.x = pg8::cvt_pk_bf16(s0[0], s0[1]); pw.y = pg8::cvt_pk_bf16(s0[2], s0[3]); pw.z = pg8::cvt_pk_bf16(s1[0], s1[1]); pw.w = pg8::cvt_pk_bf16(s1[2], s1[3]);
    const bf16x8 pf = __builtin_bit_cast(bf16x8, pw);
#pragma unroll
    for (int et = 0; et < 4; ++et) O[et] = MFMA16(tile_trfrag(Vt, key0, et, lane), pf, O[et]);
}
__device__ __forceinline__ void st_pairs(LAS unsigned char* Kt, const bf16x8 (&qf)[2], int np, f32x4 (&S)[16], int lane) {
    const int i = lane & 15, g = lane >> 4;
    bf16x8 kf[2][2][2];
    kf[0][0][0] = tile_rowfrag(Kt, i, g); kf[0][0][1] = tile_rowfrag(Kt, i, 4 + g); kf[0][1][0] = tile_rowfrag(Kt, 16 + i, g); kf[0][1][1] = tile_rowfrag(Kt, 16 + i, 4 + g);
#pragma unroll
    for (int p = 0; p < 8; ++p) {
        if (p < np) {
            if (p + 1 < np) { const int r = 32 * (p + 1) + i;
                kf[(p + 1) & 1][0][0] = tile_rowfrag(Kt, r, g); kf[(p + 1) & 1][0][1] = tile_rowfrag(Kt, r, 4 + g); kf[(p + 1) & 1][1][0] = tile_rowfrag(Kt, r + 16, g); kf[(p + 1) & 1][1][1] = tile_rowfrag(Kt, r + 16, 4 + g); }
            __builtin_amdgcn_sched_barrier(0);
            f32x4 a0 = (f32x4){0.f, 0.f, 0.f, 0.f}, a1 = a0;
            a0 = MFMA16(kf[p & 1][0][0], qf[0], a0); a1 = MFMA16(kf[p & 1][1][0], qf[0], a1);
            a0 = MFMA16(kf[p & 1][0][1], qf[1], a0); a1 = MFMA16(kf[p & 1][1][1], qf[1], a1);
            S[2 * p] = a0; S[2 * p + 1] = a1;
            __builtin_amdgcn_sched_barrier(0);
        }
    }
}
__device__ __forceinline__ void trfrag4(LAS unsigned char* Vt, int key0, bf16x8 (&vf)[4], int lane) {
#pragma unroll
    for (int et = 0; et < 4; ++et) vf[et] = tile_trfrag(Vt, key0, et, lane);
}
__device__ __forceinline__ float grp4_sum(float v) { v += __shfl_xor(v, 16); v += __shfl_xor(v, 32); return v; }
__device__ __forceinline__ float grp4_max(float v) { v = fmaxf(v, __shfl_xor(v, 16)); v = fmaxf(v, __shfl_xor(v, 32)); return v; }

__device__ __forceinline__ void headnorm_store_pre(f32x4 (&O)[4], const f32x4 (&nw4)[4], const uint2 (&gt)[4], bf16_t* grow, int lane) {
    const int g = lane >> 4;
    float s = 0.f;
#pragma unroll
    for (int et = 0; et < 4; ++et) s += (O[et][0] + O[et][1]) + (O[et][2] + O[et][3]);
    const float mu = grp4_sum(s) * (1.f / 64.f);
    float q = 0.f;
#pragma unroll
    for (int et = 0; et < 4; ++et)
#pragma unroll
        for (int r = 0; r < 4; ++r) { const float d = O[et][r] - mu; q += d * d; }
    const float rstd = rsqrtf(grp4_sum(q) * (1.f / 64.f) + 1e-5f);
#pragma unroll
    for (int et = 0; et < 4; ++et) {
        const uint2 gw = gt[et]; const f32x4 w4 = nw4[et];
        const float g0 = __uint_as_float(gw.x << 16), g1 = __uint_as_float(gw.x & 0xffff0000u), g2 = __uint_as_float(gw.y << 16), g3 = __uint_as_float(gw.y & 0xffff0000u);
        uint2 o;
        o.x = pk2((O[et][0] - mu) * rstd * w4[0] * siluf(g0), (O[et][1] - mu) * rstd * w4[1] * siluf(g1));
        o.y = pk2((O[et][2] - mu) * rstd * w4[2] * siluf(g2), (O[et][3] - mu) * rstd * w4[3] * siluf(g3));
        *(uint2*)(grow + et * 16 + 4 * g) = o;
    }
}
__device__ __forceinline__ int tile16_of(int wave, int k) { return k == 0 ? 15 - wave : (k == 1 ? wave : (k == 2 ? 8 + wave : 7 - wave)); }

template <int NTOK>
__device__ __forceinline__ void kvt_mfma(const GCtx& c, float* out) {
    LAS unsigned char* Kt = c.lds + LDS_KT; LAS unsigned char* Vt = c.lds + LDS_VT;
    const int et = c.wave, i = c.lane & 15, g = c.lane >> 4;
    f32x4 acc[4];
#pragma unroll
    for (int dt = 0; dt < 4; ++dt) acc[dt] = (f32x4){0.f, 0.f, 0.f, 0.f};
#pragma unroll
    for (int s = 0; s < NTOK / 32; ++s) {
        const bf16x8 af = tile_trfrag(Vt, 32 * s, et, c.lane);
#pragma unroll
        for (int dt = 0; dt < 4; ++dt) acc[dt] = MFMA16(af, tile_trfrag(Kt, 32 * s, dt, c.lane), acc[dt]);
    }
#pragma unroll
    for (int dt = 0; dt < 4; ++dt)
#pragma unroll
        for (int r = 0; r < 4; ++r) out[(et * 16 + 4 * g + r) * 64 + dt * 16 + i] = acc[dt][r];
}

template <bool ZETA>
__device__ __forceinline__ void ret_stage(const GCtx& c, const Args& a, int h, int T0, float lg2g) {
    const bf16_t* proj = (const bf16_t*)(a.ws + WS_PROJ); const float2* rope = (const float2*)(a.ws + WS_ROPE);
    LAS unsigned char* Kt = c.lds + LDS_KT; LAS unsigned char* Vt = c.lds + LDS_VT;
#pragma unroll
    for (int half = 0; half < 2; ++half) {
        u32x4 klo[2], khi[2], vv[4]; f32x4 rr[2][4];
#pragma unroll
        for (int q = 0; q < 2; ++q) { const int it = c.tid + (2 * half + q) * GT, row = it >> 2, cq = it & 3; const size_t t = (size_t)(T0 + row);
            klo[q] = *(const u32x4*)(proj + t * NP + C_BK + h * 64 + 8 * cq); khi[q] = *(const u32x4*)(proj + t * NP + C_BK + h * 64 + 32 + 8 * cq);
            const f32x4* rp = (const f32x4*)(rope + t * 32 + 8 * cq);
#pragma unroll
            for (int j = 0; j < 4; ++j) rr[q][j] = rp[j]; }
#pragma unroll
        for (int q = 0; q < 4; ++q) { const int it = c.tid + (4 * half + q) * GT, row = it >> 3, c16 = it & 7; vv[q] = *(const u32x4*)(proj + (size_t)(T0 + row) * NP + C_BV + h * 64 + 8 * c16); }
#pragma unroll
        for (int q = 0; q < 2; ++q) { const int it = c.tid + (2 * half + q) * GT, row = it >> 2, cq = it & 3;
            const float sc = ZETA ? 0.125f * exp2f(lg2g * (float)(255 - row)) : 0.125f;
            float lo[8], hi[8], olo[8], ohi[8]; unpack8(klo[q], lo); unpack8(khi[q], hi);
#pragma unroll
            for (int j2 = 0; j2 < 4; ++j2) { const f32x4 cs = rr[q][j2];
                olo[2 * j2] = (lo[2 * j2] * cs[0] - hi[2 * j2] * cs[1]) * sc; ohi[2 * j2] = (lo[2 * j2] * cs[1] + hi[2 * j2] * cs[0]) * sc;
                olo[2 * j2 + 1] = (lo[2 * j2 + 1] * cs[2] - hi[2 * j2 + 1] * cs[3]) * sc; ohi[2 * j2 + 1] = (lo[2 * j2 + 1] * cs[3] + hi[2 * j2 + 1] * cs[2]) * sc; }
            tile_store8(Kt, row, cq, olo); tile_store8(Kt, row, 4 + cq, ohi); }
#pragma unroll
        for (int q = 0; q < 4; ++q) { const int it = c.tid + (4 * half + q) * GT, row = it >> 3, c16 = it & 7; *(LAS u32x4*)(Vt + TILE_OFF(row, c16)) = vv[q]; }
    }
}
__device__ __forceinline__ void ret_x1_unit(GCtx& c, const Args& a, int h, int ch) {
    const float lg2g = log2f(1.f - exp2f(-5.f - (float)h));
    ret_stage<true>(c, a, h, ch * 256, lg2g);
    gsync(c);
    kvt_mfma<256>(c, (float*)(a.ws + WS_KVRET) + ((size_t)h * 64 + ch) * 4096);
    gsync(c);
}
struct RetPre { u32x4 qlo, qhi; f32x4 rp[4]; uint2 gt[4]; };
__device__ __forceinline__ void ret_prefetch(const GCtx& c, const Args& a, int h, int ch, int wt, RetPre& p) {
    const bf16_t* proj = (const bf16_t*)(a.ws + WS_PROJ); const float2* rope = (const float2*)(a.ws + WS_ROPE);
    const int i = c.lane & 15, g = c.lane >> 4, t = ch * 256 + wt * 16 + i;
    const bf16_t* qrow = proj + (size_t)t * NP + C_BQ + h * 64;
    p.qlo = *(const u32x4*)(qrow + 8 * g); p.qhi = *(const u32x4*)(qrow + 32 + 8 * g);
    const f32x4* rp = (const f32x4*)(rope + (size_t)t * 32 + 8 * g);
#pragma unroll
    for (int j = 0; j < 4; ++j) p.rp[j] = rp[j];
#pragma unroll
    for (int et = 0; et < 4; ++et) p.gt[et] = *(const uint2*)(proj + (size_t)t * NP + C_BG + h * 64 + et * 16 + 4 * g);
}
__device__ __forceinline__ void ret_compute(const GCtx& c, const Args& a, int h, int ch, int wt, float lg2g, const RetPre& p, const f32x4 (&nw4)[4]) {
    bf16_t* proj = (bf16_t*)(a.ws + WS_PROJ);
    LAS unsigned char* Kt = c.lds + LDS_KT; LAS unsigned char* Vt = c.lds + LDS_VT;
    const int i = c.lane & 15, g = c.lane >> 4, ql = wt * 16 + i, t = ch * 256 + ql;
    bf16x8 sf[4][2];
    { const bf16_t* St = (const bf16_t*)(a.ws + WS_RPREV) + ((size_t)h * 64 + ch) * 4096;
#pragma unroll
      for (int et = 0; et < 4; ++et) { const bf16_t* rp = St + (size_t)(et * 16 + i) * 64 + 8 * g; sf[et][0] = *(const bf16x8*)rp; sf[et][1] = *(const bf16x8*)(rp + 32); } }
    bf16x8 qf[2];
    {
        float lo[8], hi[8], olo[8], ohi[8];
        unpack8(p.qlo, lo); unpack8(p.qhi, hi);
#pragma unroll
        for (int j2 = 0; j2 < 4; ++j2) { const f32x4 cs = p.rp[j2];
            olo[2 * j2] = lo[2 * j2] * cs[0] - hi[2 * j2] * cs[1]; ohi[2 * j2] = lo[2 * j2] * cs[1] + hi[2 * j2] * cs[0];
            olo[2 * j2 + 1] = lo[2 * j2 + 1] * cs[2] - hi[2 * j2 + 1] * cs[3]; ohi[2 * j2 + 1] = lo[2 * j2 + 1] * cs[3] + hi[2 * j2 + 1] * cs[2]; }
        qf[0] = __builtin_bit_cast(bf16x8, pack8(olo)); qf[1] = __builtin_bit_cast(bf16x8, pack8(ohi));
    }
    const float F1 = exp2f(-lg2g), F2 = F1 * F1, F3 = F2 * F1, c16 = exp2f(-16.f * lg2g);
    float Ekt = exp2f(lg2g * (float)(ql - 4 * g));
    const bool m0 = (4 * g + 0) <= i, m1 = (4 * g + 1) <= i, m2 = (4 * g + 2) <= i, m3 = (4 * g + 3) <= i;
    const int np = (wt >> 1) + 1;
    f32x4 S[16];
    st_pairs(Kt, qf, np, S, c.lane);
    f32x4 O[4];
#pragma unroll
    for (int et = 0; et < 4; ++et) O[et] = (f32x4){0.f, 0.f, 0.f, 0.f};
    bf16x8 vf[2][4];
    trfrag4(Vt, 0, vf[0], c.lane);
#pragma unroll
    for (int s = 0; s < 8; ++s) {
        if (s < np) {
            if (s + 1 < np) trfrag4(Vt, 32 * (s + 1), vf[(s + 1) & 1], c.lane);
            __builtin_amdgcn_sched_barrier(0);
            u32x4 pw;
#pragma unroll
            for (int hh = 0; hh < 2; ++hh) { const int kt = 2 * s + hh;
                f32x4 v = S[kt];
                v[0] *= Ekt; v[1] *= Ekt * F1; v[2] *= Ekt * F2; v[3] *= Ekt * F3;
                if (kt == wt) { v[0] = m0 ? v[0] : 0.f; v[1] = m1 ? v[1] : 0.f; v[2] = m2 ? v[2] : 0.f; v[3] = m3 ? v[3] : 0.f; }
                if (kt > wt) v = (f32x4){0.f, 0.f, 0.f, 0.f};
                Ekt *= c16;
                if (hh == 0) { pw.x = pk2(v[0], v[1]); pw.y = pk2(v[2], v[3]); } else { pw.z = pk2(v[0], v[1]); pw.w = pk2(v[2], v[3]); } }
            const bf16x8 pf = __builtin_bit_cast(bf16x8, pw);
#pragma unroll
            for (int et = 0; et < 4; ++et) O[et] = MFMA16(vf[s & 1][et], pf, O[et]);
            __builtin_amdgcn_sched_barrier(0);
        }
    }
    const float xi = exp2f(lg2g * (float)(ql + 1));
#pragma unroll
    for (int et = 0; et < 4; ++et) {
        f32x4 x = (f32x4){0.f, 0.f, 0.f, 0.f};
        x = MFMA16(sf[et][0], qf[0], x); x = MFMA16(sf[et][1], qf[1], x);
        O[et] += x * xi;
    }
    headnorm_store_pre(O, nw4, p.gt, proj + (size_t)t * NP + C_BG + h * 64, c.lane);
}
__device__ __forceinline__ void ret_x3_unit(GCtx& c, const Args& a, int l, int h, int ch) {
    const float lg2g = log2f(1.f - exp2f(-5.f - (float)h));
    const int g = c.lane >> 4;
    RetPre cur; ret_prefetch(c, a, h, ch, tile16_of(c.wave, 0), cur);
    f32x4 nw4[4];
#pragma unroll
    for (int et = 0; et < 4; ++et) nw4[et] = *(const f32x4*)(a.ret_nw + (size_t)l * 256 + h * 64 + et * 16 + 4 * g);
    ret_stage<false>(c, a, h, ch * 256, lg2g);
    gsync(c);
#pragma unroll 1
    for (int k = 0; k < 4; ++k) {
        UNIT_FENCE(c);
        RetPre nxt; ret_prefetch(c, a, h, ch, tile16_of(c.wave, k < 3 ? k + 1 : 3), nxt);
        ret_compute(c, a, h, ch, tile16_of(c.wave, k), lg2g, cur, nw4);
        cur = nxt;
    }
    gsync(c);
}

__device__ __forceinline__ void conv8_raw(const u32x4 (&x)[4], const LAS float* cwl, const LAS float* cbl, int chl, int t, float (&out)[8]) {
    float acc[8];
    { const f32x4 b0 = *(const LAS f32x4*)(cbl + chl), b1 = *(const LAS f32x4*)(cbl + chl + 4);
      acc[0] = b0[0]; acc[1] = b0[1]; acc[2] = b0[2]; acc[3] = b0[3]; acc[4] = b1[0]; acc[5] = b1[1]; acc[6] = b1[2]; acc[7] = b1[3]; }
#pragma unroll
    for (int tap = 0; tap < 4; ++tap) {
        float xv[8]; unpack8(x[tap], xv);
        const float on = (t - 3 + tap) >= 0 ? 1.f : 0.f;
        const f32x4 w0 = *(const LAS f32x4*)(cwl + tap * 64 + chl) * on, w1 = *(const LAS f32x4*)(cwl + tap * 64 + chl + 4) * on;
        acc[0] = fmaf(w0[0], xv[0], acc[0]); acc[1] = fmaf(w0[1], xv[1], acc[1]); acc[2] = fmaf(w0[2], xv[2], acc[2]); acc[3] = fmaf(w0[3], xv[3], acc[3]);
        acc[4] = fmaf(w1[0], xv[4], acc[4]); acc[5] = fmaf(w1[1], xv[5], acc[5]); acc[6] = fmaf(w1[2], xv[6], acc[6]); acc[7] = fmaf(w1[3], xv[7], acc[7]);
    }
#pragma unroll
    for (int j = 0; j < 8; ++j) out[j] = siluf(acc[j]);
}
#define ML_CONV_OFF 896
__device__ __forceinline__ void ml_conv_to_lds(const GCtx& c, const Args& a, int l, int h) {
    const float* cw = a.conv_w + (size_t)l * 4 * 512; const float* cb = a.conv_b + (size_t)l * 512;
    LAS float* dst = (LAS float*)c.scr + ML_CONV_OFF;
    for (int i = c.tid; i < 640; i += GT) {
        const int seg = i >> 6, ch = h * 64 + (i & 63);
        dst[i] = seg < 4 ? cw[seg * 512 + ch] : (seg == 4 ? cb[ch] : (seg < 9 ? cw[(seg - 5) * 512 + 256 + ch] : cb[256 + ch]));
    }
}
__device__ __forceinline__ void load_taps(const bf16_t* proj, int col, int t, u32x4 (&x)[4]) {
#pragma unroll
    for (int tap = 0; tap < 4; ++tap) { const int tt = t - 3 + tap; x[tap] = *(const u32x4*)(proj + (size_t)(tt < 0 ? 0 : tt) * NP + col); }
}
__device__ __forceinline__ void ml_load_kv(const GCtx& c, const Args& a, int h, int T0, int half, u32x4 (&kx)[2][4], u32x4 (&vv)[2]) {
    const bf16_t* proj = (const bf16_t*)(a.ws + WS_PROJ);
#pragma unroll
    for (int q = 0; q < 2; ++q) { const int it = c.tid + (2 * half + q) * GT, row = it >> 3, c16 = it & 7;
        load_taps(proj, C_CK + h * 64 + 8 * c16, T0 + row, kx[q]); vv[q] = *(const u32x4*)(proj + (size_t)(T0 + row) * NP + C_CV + h * 64 + 8 * c16); }
}
__device__ __forceinline__ void ml_store_kv(const GCtx& c, const Args& a, int l, int h, int T0, int half, const u32x4 (&kx)[2][4], const u32x4 (&vv)[2], const LAS float* wrow) {
    const LAS float* cv = (const LAS float*)c.scr + ML_CONV_OFF;
    LAS unsigned char* Kt = c.lds + LDS_KT; LAS unsigned char* Vt = c.lds + LDS_VT;
#pragma unroll
    for (int q = 0; q < 2; ++q) { const int it = c.tid + (2 * half + q) * GT, row = it >> 3, c16 = it & 7;
        float k8[8]; conv8_raw(kx[q], cv + 320, cv + 576, 8 * c16, T0 + row, k8);
        const float sc = wrow ? 0.125f * wrow[row] : 0.125f;
#pragma unroll
        for (int j = 0; j < 8; ++j) k8[j] *= sc;
        tile_store8(Kt, row, c16, k8); *(LAS u32x4*)(Vt + TILE_OFF(row, c16)) = vv[q]; }
}
__device__ __forceinline__ float log_sigmoid(float f) { return fminf(f, 0.f) - 0.6931471805599453f * __builtin_amdgcn_logf(1.f + __builtin_amdgcn_exp2f(-1.4426950408889634f * fabsf(f))); }
__device__ __forceinline__ void ml_x1_unit(GCtx& c, const Args& a, int l, int h, int ch) {
    LAS float* sb = (LAS float*)c.scr; LAS float* si = sb + 128; LAS float* sw = sb + 256; LAS float* red = sb + 384;
    const float* gates = (const float*)(a.ws + WS_GATES);
    const int T0 = ch * 128;
    float fg = 0.f, ig = 0.f;
    if (c.tid < 128) { fg = gates[(size_t)(T0 + c.tid) * 8 + 4 + h]; ig = gates[(size_t)(T0 + c.tid) * 8 + h]; }
    u32x4 kx[2][4], vv[2]; ml_load_kv(c, a, h, T0, 0, kx, vv);
    ml_conv_to_lds(c, a, l, h);
    if (c.tid < 128) { sb[c.tid] = log_sigmoid(fg + a.gate_bias[l * 8 + 4 + h]); si[c.tid] = ig + a.gate_bias[l * 8 + h]; }
    gsync(c);
    if (c.wave == 0) {
        const float v0 = sb[2 * c.lane], v1 = sb[2 * c.lane + 1];
        float s = v0 + v1;
#pragma unroll
        for (int o = 1; o < 64; o <<= 1) { const float nb = __shfl_up(s, o); if (c.lane >= o) s += nb; }
        const float b0 = s - v1, b1 = s, bl = __shfl(s, 63);
        const float g0 = bl - b0 + si[2 * c.lane], g1 = bl - b1 + si[2 * c.lane + 1];
        float m = fmaxf(g0, g1);
#pragma unroll
        for (int o = 1; o < 64; o <<= 1) m = fmaxf(m, __shfl_xor(m, o));
        sw[2 * c.lane] = __expf(g0 - m); sw[2 * c.lane + 1] = __expf(g1 - m);
        if (c.lane == 0) { ((float*)(a.ws + WS_MLOC))[h * 128 + ch] = m; ((float*)(a.ws + WS_BC))[h * 128 + ch] = bl; }
    }
    gsync(c);
    ml_store_kv(c, a, l, h, T0, 0, kx, vv, sw);
    ml_load_kv(c, a, h, T0, 1, kx, vv);
    ml_store_kv(c, a, l, h, T0, 1, kx, vv, sw);
    gsync(c);
    kvt_mfma<128>(c, (float*)(a.ws + WS_KVML) + ((size_t)h * 128 + ch) * 4096);
    {
        LAS unsigned char* Kt = c.lds + LDS_KT;
        const int d = c.tid & 63, part = c.tid >> 6;
        float s = 0.f;
#pragma unroll
        for (int r = 0; r < 32; ++r) { const int row = part * 32 + r; s += bf2f(*(const LAS bf16_t*)(Kt + TILE_OFF(row, d >> 3) + (d & 7) * 2)); }
        red[part * 64 + d] = s;
    }
    gsync(c);
    if (c.tid < 64) ((float*)(a.ws + WS_NLOC))[((size_t)h * 128 + ch) * 64 + c.tid] = (red[c.tid] + red[64 + c.tid]) + (red[128 + c.tid] + red[192 + c.tid]);
    gsync(c);
}
struct MlPre { u32x4 qx[2][4]; };
__device__ __forceinline__ void ml_prefetch(const GCtx& c, const Args& a, int h, int ch, int wt, MlPre& p) {
    const bf16_t* proj = (const bf16_t*)(a.ws + WS_PROJ);
    const int i = c.lane & 15, g = c.lane >> 4, t = ch * 128 + wt * 16 + i;
    load_taps(proj, C_CQ + h * 64 + 8 * g, t, p.qx[0]); load_taps(proj, C_CQ + h * 64 + 32 + 8 * g, t, p.qx[1]);
}
__device__ __forceinline__ void ml_compute(const GCtx& c, const Args& a, int l, int h, int ch, int cc, int wt, float m_st, const f32x4 (&nw4)[4],
                                           const LAS float* sb, const LAS float* su, const LAS float* sM, const LAS float* sn) {
    bf16_t* proj = (bf16_t*)(a.ws + WS_PROJ);
    LAS unsigned char* Kt = c.lds + LDS_KT; LAS unsigned char* Vt = c.lds + LDS_VT;
    const LAS float* cv = (const LAS float*)c.scr + ML_CONV_OFF;
    const int i = c.lane & 15, g = c.lane >> 4, ql = wt * 16 + i, t = ch * 128 + ql;
    MlPre p; ml_prefetch(c, a, h, ch, wt, p);
    bf16x8 sf[4][2]; uint2 ot[4], gt[4];
    { const bf16_t* St = (const bf16_t*)(a.ws + WS_CPREV) + ((size_t)h * 128 + ch) * 4096;
#pragma unroll
      for (int et = 0; et < 4; ++et) { const bf16_t* rp = St + (size_t)(et * 16 + i) * 64 + 8 * g; sf[et][0] = *(const bf16x8*)rp; sf[et][1] = *(const bf16x8*)(rp + 32);
          ot[et] = *(const uint2*)(proj + (size_t)t * NP + C_CO + h * 64 + et * 16 + 4 * g); gt[et] = *(const uint2*)(proj + (size_t)t * NP + C_CG + h * 64 + et * 16 + 4 * g); } }
    bf16x8 qf[2]; float qn;
    {
        float q0[8], q1[8];
        conv8_raw(p.qx[0], cv, cv + 256, 8 * g, t, q0); conv8_raw(p.qx[1], cv, cv + 256, 32 + 8 * g, t, q1);
        qf[0] = __builtin_bit_cast(bf16x8, pack8(q0)); qf[1] = __builtin_bit_cast(bf16x8, pack8(q1));
        float s = 0.f;
#pragma unroll
        for (int j = 0; j < 8; ++j) s += q0[j] * sn[64 * cc + 8 * g + j] + q1[j] * sn[64 * cc + 32 + 8 * g + j];
        qn = grp4_sum(s);
    }
    const float Mq = sM[128 * cc + ql];
    const bool m0 = (4 * g + 0) <= i, m1 = (4 * g + 1) <= i, m2 = (4 * g + 2) <= i, m3 = (4 * g + 3) <= i;
    const int np = (wt >> 1) + 1;
    f32x4 S[16]; float rs = 0.f;
    st_pairs(Kt + 128 * cc * 128, qf, np, S, c.lane);
    f32x4 O[4];
#pragma unroll
    for (int et = 0; et < 4; ++et) O[et] = (f32x4){0.f, 0.f, 0.f, 0.f};
    bf16x8 vf[2][4];
    trfrag4(Vt, 128 * cc, vf[0], c.lane);
#pragma unroll
    for (int s = 0; s < 4; ++s) {
        if (s < np) {
            if (s + 1 < np) trfrag4(Vt, 128 * cc + 32 * (s + 1), vf[(s + 1) & 1], c.lane);
            __builtin_amdgcn_sched_barrier(0);
            u32x4 pw;
#pragma unroll
            for (int hh = 0; hh < 2; ++hh) { const int kt = 2 * s + hh;
                f32x4 v = S[kt];
                const f32x4 u4 = *(const LAS f32x4*)(su + 128 * cc + kt * 16 + 4 * g);
                v[0] *= __expf(u4[0] - Mq); v[1] *= __expf(u4[1] - Mq); v[2] *= __expf(u4[2] - Mq); v[3] *= __expf(u4[3] - Mq);
                if (kt == wt) { v[0] = m0 ? v[0] : 0.f; v[1] = m1 ? v[1] : 0.f; v[2] = m2 ? v[2] : 0.f; v[3] = m3 ? v[3] : 0.f; }
                if (kt > wt) v = (f32x4){0.f, 0.f, 0.f, 0.f};
                rs += (v[0] + v[1]) + (v[2] + v[3]);
                if (hh == 0) { pw.x = pk2(v[0], v[1]); pw.y = pk2(v[2], v[3]); } else { pw.z = pk2(v[0], v[1]); pw.w = pk2(v[2], v[3]); } }
            const bf16x8 pf = __builtin_bit_cast(bf16x8, pw);
#pragma unroll
            for (int et = 0; et < 4; ++et) O[et] = MFMA16(vf[s & 1][et], pf, O[et]);
            __builtin_amdgcn_sched_barrier(0);
        }
    }
    rs = grp4_sum(rs);
    const float winter = __expf(m_st - Mq);
    const float den = rs + winter * qn;
    const float inv = 1.f / fmaxf(fabsf(den), __expf(-(sb[128 * cc + ql] + Mq)));
#pragma unroll
    for (int et = 0; et < 4; ++et) {
        f32x4 x = (f32x4){0.f, 0.f, 0.f, 0.f};
        x = MFMA16(sf[et][0], qf[0], x); x = MFMA16(sf[et][1], qf[1], x);
        const uint2 ow = ot[et];
        f32x4 hv = (O[et] + x * winter) * inv;
        hv[0] *= sigmf(__uint_as_float(ow.x << 16)); hv[1] *= sigmf(__uint_as_float(ow.x & 0xffff0000u)); hv[2] *= sigmf(__uint_as_float(ow.y << 16)); hv[3] *= sigmf(__uint_as_float(ow.y & 0xffff0000u));
        O[et] = hv;
    }
    headnorm_store_pre(O, nw4, gt, proj + (size_t)t * NP + C_CG + h * 64, c.lane);
}
__device__ __forceinline__ void ml_x3_unit(GCtx& c, const Args& a, int l, int h, int ch0) {
    LAS float* sb = (LAS float*)c.scr; LAS float* su = sb + 256; LAS float* sM = sb + 512; LAS float* sn = sb + 768;
    const float* gates = (const float*)(a.ws + WS_GATES);
    const int T0 = ch0 * 128;
    const float fg = gates[(size_t)(T0 + c.tid) * 8 + 4 + h], ig = gates[(size_t)(T0 + c.tid) * 8 + h];
    const float m_st0 = ((const float*)(a.ws + WS_MPREV))[h * 128 + ch0], m_st1 = ((const float*)(a.ws + WS_MPREV))[h * 128 + ch0 + 1];
    float nst = 0.f; if (c.wave >= 2) nst = ((const float*)(a.ws + WS_NPREV))[((size_t)h * 128 + ch0 + (c.wave - 2)) * 64 + c.lane];
    u32x4 kx[2][4], vv[2]; ml_load_kv(c, a, h, T0, 0, kx, vv);
    ml_conv_to_lds(c, a, l, h);
    sb[c.tid] = log_sigmoid(fg + a.gate_bias[l * 8 + 4 + h]); su[c.tid] = ig + a.gate_bias[l * 8 + h];
    if (c.wave >= 2) sn[(c.wave - 2) * 64 + c.lane] = nst;
    gsync(c);
    if (c.wave < 2) {
        LAS float* b = sb + 128 * c.wave; LAS float* u = su + 128 * c.wave; LAS float* M = sM + 128 * c.wave;
        const float m_st = c.wave ? m_st1 : m_st0;
        const float v0 = b[2 * c.lane], v1 = b[2 * c.lane + 1];
        float s = v0 + v1;
#pragma unroll
        for (int o = 1; o < 64; o <<= 1) { const float nb = __shfl_up(s, o); if (c.lane >= o) s += nb; }
        const float b0 = s - v1, b1 = s;
        const float u0 = u[2 * c.lane] - b0, u1 = u[2 * c.lane + 1] - b1;
        float m = fmaxf(u0, u1);
#pragma unroll
        for (int o = 1; o < 64; o <<= 1) { const float nb = __shfl_up(m, o); if (c.lane >= o) m = fmaxf(m, nb); }
        float mprev = __shfl_up(m, 1); if (c.lane == 0) mprev = -INFINITY;
        b[2 * c.lane] = b0; b[2 * c.lane + 1] = b1; u[2 * c.lane] = u0; u[2 * c.lane + 1] = u1;
        M[2 * c.lane] = fmaxf(m_st, fmaxf(mprev, u0)); M[2 * c.lane + 1] = fmaxf(m_st, m);
    }
    ml_store_kv(c, a, l, h, T0, 0, kx, vv, nullptr);
#pragma unroll 1
    for (int half = 1; half < 4; ++half) { ml_load_kv(c, a, h, T0, half, kx, vv); ml_store_kv(c, a, l, h, T0, half, kx, vv, nullptr); }
    gsync(c);
    f32x4 nw4[4];
#pragma unroll
    for (int et = 0; et < 4; ++et) nw4[et] = *(const f32x4*)(a.ml_nw + (size_t)l * 256 + h * 64 + et * 16 + 4 * (c.lane >> 4));
#pragma unroll 1
    for (int k = 0; k < 4; ++k) {
        UNIT_FENCE(c);
        const int cc = k >> 1;
        ml_compute(c, a, l, h, ch0 + cc, cc, (k & 1) ? c.wave : 7 - c.wave, cc ? m_st1 : m_st0, nw4, sb, su, sM, sn);
    }
    gsync(c);
}

__device__ __forceinline__ void ret_scan_unit(GCtx& c, const Args& a, int h, int part) {
    const float* kv = (const float*)(a.ws + WS_KVRET) + (size_t)h * 64 * 4096 + part * GT + c.tid;
    bf16_t* rp = (bf16_t*)(a.ws + WS_RPREV) + (size_t)h * 64 * 4096 + part * GT + c.tid;
    const float dec = exp2f(256.f * log2f(1.f - exp2f(-5.f - (float)h)));
    float st = 0.f;
    for (int c0 = 0; c0 < 64; c0 += 32) {
        float v[32];
#pragma unroll
        for (int j = 0; j < 32; ++j) v[j] = kv[(size_t)(c0 + j) * 4096];
#pragma unroll
        for (int j = 0; j < 32; ++j) { rp[(size_t)(c0 + j) * 4096] = f2bf(st); st = fmaf(dec, st, v[j]); }
    }
}
__device__ __forceinline__ void ml_scan_unit(GCtx& c, const Args& a, int h, int part) {
    LAS float* sa = (LAS float*)c.scr; LAS float* swl = sa + 128;
    const float* mloc = (const float*)(a.ws + WS_MLOC) + h * 128; const float* bc = (const float*)(a.ws + WS_BC) + h * 128;
    if (c.wave == 0) {
        const float B0 = bc[2 * c.lane], B1 = bc[2 * c.lane + 1], L0 = mloc[2 * c.lane], L1 = mloc[2 * c.lane + 1];
        float s = B0 + B1;
#pragma unroll
        for (int o = 1; o < 64; o <<= 1) { const float nb = __shfl_up(s, o); if (c.lane >= o) s += nb; }
        const float pb0 = s - (B0 + B1), pb1 = pb0 + B0, pb2 = s;
        const float y0 = L0 - pb1, y1 = L1 - pb2;
        float mx = fmaxf(y0, y1);
#pragma unroll
        for (int o = 1; o < 64; o <<= 1) { const float nb = __shfl_up(mx, o); if (c.lane >= o) mx = fmaxf(mx, nb); }
        float mxp = __shfl_up(mx, 1); if (c.lane == 0) mxp = -INFINITY;
        const float X0 = fmaxf(0.f, mxp), X1 = fmaxf(X0, y0), X2 = fmaxf(X1, y1);
        const float m0 = pb0 + X0, m1 = pb1 + X1, m2 = pb2 + X2;
        sa[2 * c.lane] = __expf(B0 + m0 - m1); swl[2 * c.lane] = __expf(L0 - m1);
        sa[2 * c.lane + 1] = __expf(B1 + m1 - m2); swl[2 * c.lane + 1] = __expf(L1 - m2);
        if (part == 0) { float* mp = (float*)(a.ws + WS_MPREV) + h * 128; mp[2 * c.lane] = m0; mp[2 * c.lane + 1] = m1; }
    }
    gsync(c);
    const int idx = part * GT + c.tid;
    if (idx < 4160) {
        const bool isC = idx < 4096;
        const float* src = isC ? (const float*)(a.ws + WS_KVML) + (size_t)h * 128 * 4096 + idx : (const float*)(a.ws + WS_NLOC) + (size_t)h * 128 * 64 + (idx - 4096);
        const size_t sstride = isC ? 4096 : 64;
        bf16_t* cp = (bf16_t*)(a.ws + WS_CPREV) + (size_t)h * 128 * 4096 + idx;
        float* np = (float*)(a.ws + WS_NPREV) + (size_t)h * 128 * 64 + (idx - 4096);
        float st = 0.f;
        for (int c0 = 0; c0 < 128; c0 += 32) {
            float v[32];
#pragma unroll
            for (int j = 0; j < 32; ++j) v[j] = src[(size_t)(c0 + j) * sstride];
#pragma unroll
            for (int j = 0; j < 32; ++j) {
                if (isC) cp[(size_t)(c0 + j) * 4096] = f2bf(st); else np[(size_t)(c0 + j) * 64] = st;
                st = sa[c0 + j] * st + swl[c0 + j] * v[j];
            }
        }
    }
    gsync(c);
}
#define CW_CNT(l) (4096 + (l) * 512)
#define MOBA_C1 0.18033688011112042f
__device__ __forceinline__ int list_off(int n) { return 16384 * n - 128 * n * (n + 1); }
__device__ __forceinline__ bool better(float v, int n, float w, int m) { return v > w || (v == w && n < m); }
__device__ __forceinline__ void top3_insert(float v, int n, float& v0, int& i0, float& v1, int& i1, float& v2, int& i2) {
    const bool b0 = better(v, n, v0, i0), b1 = better(v, n, v1, i1), b2 = better(v, n, v2, i2);
    const float nv2 = b1 ? v1 : (b2 ? v : v2); const int ni2 = b1 ? i1 : (b2 ? n : i2);
    const float nv1 = b0 ? v0 : (b1 ? v : v1); const int ni1 = b0 ? i0 : (b1 ? n : i1);
    const float nv0 = b0 ? v : v0;             const int ni0 = b0 ? n : i0;
    v0 = nv0; i0 = ni0; v1 = nv1; i1 = ni1; v2 = nv2; i2 = ni2;
}
__device__ __forceinline__ void load_qf(const bf16_t* qrow, bf16x8 (&qf)[2], int g) { qf[0] = *(const bf16x8*)(qrow + 8 * g); qf[1] = *(const bf16x8*)(qrow + 32 + 8 * g); }

__device__ __forceinline__ void moba_gate_unit(GCtx& c, const Args& a, int l, int h, int qc) {
    const int j = qc >> 1;
    if (j == 0) return;
    const bf16_t* proj = (const bf16_t*)(a.ws + WS_PROJ); const float* kmp = (const float*)(a.ws + WS_KMP);
    LAS unsigned char* KM = c.lds + LDS_KT;
    LAS unsigned* hist = (LAS unsigned*)c.scr; LAS unsigned* base = hist + 64;
    unsigned* gcnt = (unsigned*)(a.ws + WS_CTL) + CW_CNT(l) + h * 64;
    unsigned* list = (unsigned*)(a.ws + WS_LIST) + (size_t)h * LIST_PER_HEAD;
    const int i = c.lane & 15, g = c.lane >> 4;
    bf16x8 qf[2][2];
#pragma unroll
    for (int r = 0; r < 2; ++r) load_qf(proj + (size_t)(qc * 128 + r * 64 + c.wave * 16 + i) * NP + C_AQ + h * 64, qf[r], g);
    {
        f32x4 a0[2], a1[2], b0[2], b1[2];
#pragma unroll
        for (int q = 0; q < 2; ++q) { const int it = c.tid + q * GT, n = it >> 3, c16 = it & 7;
            const float* p0 = kmp + (size_t)(2 * n) * 512 + h * 64 + 8 * c16; const float* p1 = p0 + 512;
            a0[q] = *(const f32x4*)p0; a1[q] = *(const f32x4*)(p0 + 4); b0[q] = *(const f32x4*)p1; b1[q] = *(const f32x4*)(p1 + 4); }
#pragma unroll
        for (int q = 0; q < 2; ++q) { const int it = c.tid + q * GT, n = it >> 3, c16 = it & 7;
            float v[8];
#pragma unroll
            for (int e = 0; e < 4; ++e) { v[e] = (a0[q][e] + b0[q][e]) * (1.f / 256.f); v[4 + e] = (a1[q][e] + b1[q][e]) * (1.f / 256.f); }
            tile_store8(KM, n, c16, v); }
    }
    if (c.tid < 64) hist[c.tid] = 0u;
    gsync(c);
    const int nsel = j < 3 ? j : 3;
    const bool valid = g < nsel;
    int nsl[2]; unsigned pos[2];
#pragma unroll
    for (int r = 0; r < 2; ++r) {
        float v0 = -INFINITY, v1 = -INFINITY, v2 = -INFINITY; int i0 = 0, i1 = 0, i2 = 0;
#pragma unroll
        for (int nt = 0; nt < 4; ++nt) {
            if (nt * 16 < j) {
                const f32x4 gt = st_tile(KM, nt * 16, qf[r], c.lane);
#pragma unroll
                for (int q = 0; q < 4; ++q) { const int n = nt * 16 + 4 * g + q; top3_insert(n < j ? gt[q] : -INFINITY, n, v0, i0, v1, i1, v2, i2); }
            }
        }
#pragma unroll
        for (int off = 16; off <= 32; off <<= 1) {
            const float p0 = __shfl_xor(v0, off), p1 = __shfl_xor(v1, off), p2 = __shfl_xor(v2, off);
            const int q0 = __shfl_xor(i0, off), q1 = __shfl_xor(i1, off), q2 = __shfl_xor(i2, off);
            top3_insert(p0, q0, v0, i0, v1, i1, v2, i2); top3_insert(p1, q1, v0, i0, v1, i1, v2, i2); top3_insert(p2, q2, v0, i0, v1, i1, v2, i2);
        }
        nsl[r] = g == 0 ? i0 : (g == 1 ? i1 : i2);
        pos[r] = 0u;
        if (valid) pos[r] = __hip_atomic_fetch_add(hist + nsl[r], 1u, __ATOMIC_RELAXED, __HIP_MEMORY_SCOPE_WORKGROUP);
    }
    gsync(c);
    if (c.tid < 64) { const unsigned cn = hist[c.tid]; base[c.tid] = cn ? __hip_atomic_fetch_add(gcnt + c.tid, cn, __ATOMIC_RELAXED, __HIP_MEMORY_SCOPE_AGENT) : 0u; }
    gsync(c);
    if (valid) {
#pragma unroll
        for (int r = 0; r < 2; ++r) { const int t = qc * 128 + r * 64 + c.wave * 16 + i; list[list_off(nsl[r]) + base[nsl[r]] + pos[r]] = (unsigned)(t * 4 + g); }
    }
    gsync(c);
}

__device__ __forceinline__ bf16x8 moba_cfrag(float sl2, int lane) {
    const int i = lane & 15, g = lane >> 4;
    float v[8];
#pragma unroll
    for (int j = 0; j < 4; ++j) { const float w = i == 0 ? exp2f(sl2 * (float)(4 * g + j - 15)) : 0.f; v[j] = w; v[4 + j] = w; }
    return __builtin_bit_cast(bf16x8, pack8(v));
}
__device__ __forceinline__ void pv_step_l(LAS unsigned char* Vt, int key0, const f32x4& s0, const f32x4& s1, f32x4 (&O)[4], f32x4& L, const bf16x8 cfrag, int lane) {
    u32x4 pw; pw.x = pg8::cvt_pk_bf16(s0[0], s0[1]); pw.y = pg8::cvt_pk_bf16(s0[2], s0[3]); pw.z = pg8::cvt_pk_bf16(s1[0], s1[1]); pw.w = pg8::cvt_pk_bf16(s1[2], s1[3]);
    const bf16x8 pf = __builtin_bit_cast(bf16x8, pw);
#pragma unroll
    for (int et = 0; et < 4; ++et) O[et] = MFMA16(tile_trfrag(Vt, key0, et, lane), pf, O[et]);
    L = MFMA16(cfrag, pf, L);
}
__device__ __forceinline__ void moba_sel_wave(const GCtx& c, const Args& a, int h, int n, unsigned entry, bool valid, const bf16x8 (&qf)[2], float sl2, const bf16x8 cfrag) {
    LAS unsigned char* Kt = c.lds + LDS_KT; LAS unsigned char* Vt = c.lds + LDS_VT;
    const int g = c.lane >> 4;
    const int t = (int)(entry >> 2), slot = (int)(entry & 3u);
    f32x4 S[16];
    st_pairs(Kt, qf, 8, S, c.lane);
    float am = -INFINITY;
#pragma unroll
    for (int kt = 0; kt < 16; ++kt) am = fmaxf(am, fmaxf(fmaxf(S[kt][0], S[kt][1]), fmaxf(S[kt][2], S[kt][3])));
    am = grp4_max(am) * MOBA_C1;
    f32x4 O[4], L = (f32x4){0.f, 0.f, 0.f, 0.f};
#pragma unroll
    for (int et = 0; et < 4; ++et) O[et] = (f32x4){0.f, 0.f, 0.f, 0.f};
    bf16x8 vf[2][4];
    trfrag4(Vt, 0, vf[0], c.lane);
#pragma unroll
    for (int s = 0; s < 8; ++s) {
        if (s + 1 < 8) trfrag4(Vt, 32 * (s + 1), vf[(s + 1) & 1], c.lane);
        __builtin_amdgcn_sched_barrier(0);
        u32x4 pw;
#pragma unroll
        for (int hh = 0; hh < 2; ++hh) { const int kt = 2 * s + hh;
            const float off = sl2 * (float)(16 * (kt - 15)) - am;
            const f32x4 v = S[kt];
            const float p0 = __builtin_amdgcn_exp2f(fmaf(v[0], MOBA_C1, off)), p1 = __builtin_amdgcn_exp2f(fmaf(v[1], MOBA_C1, off)), p2 = __builtin_amdgcn_exp2f(fmaf(v[2], MOBA_C1, off)), p3 = __builtin_amdgcn_exp2f(fmaf(v[3], MOBA_C1, off));
            if (hh == 0) { pw.x = pk2(p0, p1); pw.y = pk2(p2, p3); } else { pw.z = pk2(p0, p1); pw.w = pk2(p2, p3); } }
        const bf16x8 pf = __builtin_bit_cast(bf16x8, pw);
#pragma unroll
        for (int et = 0; et < 4; ++et) O[et] = MFMA16(vf[s & 1][et], pf, O[et]);
        L = MFMA16(cfrag, pf, L);
        __builtin_amdgcn_sched_barrier(0);
    }
    const float ls = __shfl(L[0], c.lane & 15);
    if (valid) {
        const float inv = 1.f / ls;
        const size_t pidx = ((size_t)t * 8 + h) * 3 + slot;
        bf16_t* po = (bf16_t*)(a.ws + WS_PART) + pidx * 64;
#pragma unroll
        for (int et = 0; et < 4; ++et) { uint2 o; o.x = pk2(O[et][0] * inv, O[et][1] * inv); o.y = pk2(O[et][2] * inv, O[et][3] * inv); *(uint2*)(po + et * 16 + 4 * g) = o; }
        if (g == 0) *(float2*)((float*)(a.ws + WS_PML) + pidx * 2) = make_float2(am + sl2 * (float)(n * 256 + 255 - t), ls);
    }
}
__device__ __forceinline__ void moba_load_kv(const GCtx& c, const Args& a, int h, int n, u32x4 (&kr)[8], u32x4 (&vr)[8]) {
    const bf16_t* proj = (const bf16_t*)(a.ws + WS_PROJ);
#pragma unroll
    for (int q = 0; q < 8; ++q) { const int it = c.tid + q * GT, row = it >> 3, c16 = it & 7;
        const bf16_t* rp = proj + (size_t)(n * 256 + row) * NP + h * 64 + 8 * c16; kr[q] = *(const u32x4*)(rp + C_AK); vr[q] = *(const u32x4*)(rp + C_AV); }
}
__device__ __forceinline__ void moba_store_kv(const GCtx& c, const u32x4 (&kr)[8], const u32x4 (&vr)[8], float sl2) {
    LAS unsigned char* Kt = c.lds + LDS_KT; LAS unsigned char* Vt = c.lds + LDS_VT;
    const float cf = exp2f(sl2 * (float)(((c.tid >> 3) & 15) - 15));
#pragma unroll
    for (int q = 0; q < 8; ++q) { const int it = c.tid + q * GT, row = it >> 3, c16 = it & 7;
        *(LAS u32x4*)(Kt + TILE_OFF(row, c16)) = kr[q];
        float v[8]; unpack8(vr[q], v);
#pragma unroll
        for (int j = 0; j < 8; ++j) v[j] *= cf;
        tile_store8(Vt, row, c16, v); }
}

struct OwnPre { bf16x8 q0, q1; float2 ml0, ml1, ml2; uint2 gt[4]; };
__device__ __forceinline__ void own_prefetch(const GCtx& c, const Args& a, int h, int j, int wt, OwnPre& p) {
    const bf16_t* proj = (const bf16_t*)(a.ws + WS_PROJ);
    const int i = c.lane & 15, g = c.lane >> 4, t = j * 256 + wt * 16 + i, nsel = j < 3 ? j : 3;
    const bf16_t* qrow = proj + (size_t)t * NP + C_AQ + h * 64;
    p.q0 = *(const bf16x8*)(qrow + 8 * g); p.q1 = *(const bf16x8*)(qrow + 32 + 8 * g);
    const size_t pbase = ((size_t)t * 8 + h) * 3;
    const float2* pml = (const float2*)((const float*)(a.ws + WS_PML)) + pbase;
    p.ml0 = make_float2(-INFINITY, 0.f); p.ml1 = p.ml0; p.ml2 = p.ml0;
    if (nsel > 0) p.ml0 = pml[0];
    if (nsel > 1) p.ml1 = pml[1];
    if (nsel > 2) p.ml2 = pml[2];
#pragma unroll
    for (int et = 0; et < 4; ++et) p.gt[et] = *(const uint2*)(proj + (size_t)t * NP + C_AG + h * 64 + et * 16 + 4 * g);
}
__device__ __forceinline__ void own_compute(const GCtx& c, const Args& a, int h, int j, int wt, const OwnPre& p) {
    bf16_t* proj = (bf16_t*)(a.ws + WS_PROJ);
    LAS unsigned char* Kt = c.lds + LDS_KT; LAS unsigned char* Vt = c.lds + LDS_VT;
    const int i = c.lane & 15, g = c.lane >> 4, ql = wt * 16 + i, t = j * 256 + ql, nsel = j < 3 ? j : 3;
    uint2 pw[3][4];
    { const bf16_t* po = (const bf16_t*)(a.ws + WS_PART) + (((size_t)t * 8 + h) * 3) * 64;
#pragma unroll
      for (int s = 0; s < 3; ++s)
#pragma unroll
          for (int et = 0; et < 4; ++et) { pw[s][et] = make_uint2(0u, 0u); if (s < nsel) pw[s][et] = *(const uint2*)(po + s * 64 + et * 16 + 4 * g); } }
    bf16x8 qf[2]; qf[0] = p.q0; qf[1] = p.q1;
    const float sl2 = exp2f(-(float)(h + 1)) * 1.4426950408889634f;
    const bf16x8 cfrag = moba_cfrag(sl2, c.lane);
    const bool m0 = (4 * g + 0) <= i, m1 = (4 * g + 1) <= i, m2 = (4 * g + 2) <= i, m3 = (4 * g + 3) <= i;
    const int np = (wt >> 1) + 1;
    f32x4 S[16];
    st_pairs(Kt, qf, np, S, c.lane);
    float m = -INFINITY;
#pragma unroll
    for (int kt = 0; kt < 16; ++kt) {
        if (kt <= wt) {
            f32x4 s = S[kt];
            if (kt == wt) { s[0] = m0 ? s[0] : -INFINITY; s[1] = m1 ? s[1] : -INFINITY; s[2] = m2 ? s[2] : -INFINITY; s[3] = m3 ? s[3] : -INFINITY; S[kt] = s; }
            m = fmaxf(m, fmaxf(fmaxf(s[0], s[1]), fmaxf(s[2], s[3])));
        }
    }
    const float mraw = grp4_max(m);
    const float ob = fmaf(mraw, -MOBA_C1, sl2 * (float)(15 - ql));
    m = mraw * MOBA_C1;
    asm volatile("" : "+v"(m));
    f32x4 O[4], L = (f32x4){0.f, 0.f, 0.f, 0.f};
#pragma unroll
    for (int et = 0; et < 4; ++et) O[et] = (f32x4){0.f, 0.f, 0.f, 0.f};
    bf16x8 vf[2][4];
    trfrag4(Vt, 0, vf[0], c.lane);
#pragma unroll
    for (int s = 0; s < 8; ++s) {
        if (s < np) {
            if (s + 1 < np) trfrag4(Vt, 32 * (s + 1), vf[(s + 1) & 1], c.lane);
            __builtin_amdgcn_sched_barrier(0);
            u32x4 pw;
#pragma unroll
            for (int hh = 0; hh < 2; ++hh) { const int kt = 2 * s + hh;
                const float off = ob + sl2 * (float)(16 * kt);
                const f32x4 v = S[kt];
                float p0 = __builtin_amdgcn_exp2f(fmaf(v[0], MOBA_C1, off)), p1 = __builtin_amdgcn_exp2f(fmaf(v[1], MOBA_C1, off)), p2 = __builtin_amdgcn_exp2f(fmaf(v[2], MOBA_C1, off)), p3 = __builtin_amdgcn_exp2f(fmaf(v[3], MOBA_C1, off));
                if (kt > wt) { p0 = 0.f; p1 = 0.f; p2 = 0.f; p3 = 0.f; }
                if (hh == 0) { pw.x = pk2(p0, p1); pw.y = pk2(p2, p3); } else { pw.z = pk2(p0, p1); pw.w = pk2(p2, p3); } }
            const bf16x8 pf = __builtin_bit_cast(bf16x8, pw);
#pragma unroll
            for (int et = 0; et < 4; ++et) O[et] = MFMA16(vf[s & 1][et], pf, O[et]);
            L = MFMA16(cfrag, pf, L);
            __builtin_amdgcn_sched_barrier(0);
        }
    }
    const float ls = __shfl(L[0], c.lane & 15);
    const float mt = fmaxf(fmaxf(m, p.ml0.x), fmaxf(p.ml1.x, p.ml2.x));
    const float aown = __builtin_amdgcn_exp2f(m - mt);
    const float a0 = nsel > 0 ? __builtin_amdgcn_exp2f(p.ml0.x - mt) * p.ml0.y : 0.f, a1 = nsel > 1 ? __builtin_amdgcn_exp2f(p.ml1.x - mt) * p.ml1.y : 0.f, a2 = nsel > 2 ? __builtin_amdgcn_exp2f(p.ml2.x - mt) * p.ml2.y : 0.f;
    const float inv = 1.f / (ls * aown + a0 + a1 + a2);
#pragma unroll
    for (int et = 0; et < 4; ++et) {
        const int e = et * 16 + 4 * g;
        f32x4 o = O[et] * aown;
        { const uint2 w = pw[0][et]; o[0] += a0 * __uint_as_float(w.x << 16); o[1] += a0 * __uint_as_float(w.x & 0xffff0000u); o[2] += a0 * __uint_as_float(w.y << 16); o[3] += a0 * __uint_as_float(w.y & 0xffff0000u); }
        { const uint2 w = pw[1][et]; o[0] += a1 * __uint_as_float(w.x << 16); o[1] += a1 * __uint_as_float(w.x & 0xffff0000u); o[2] += a1 * __uint_as_float(w.y << 16); o[3] += a1 * __uint_as_float(w.y & 0xffff0000u); }
        { const uint2 w = pw[2][et]; o[0] += a2 * __uint_as_float(w.x << 16); o[1] += a2 * __uint_as_float(w.x & 0xffff0000u); o[2] += a2 * __uint_as_float(w.y << 16); o[3] += a2 * __uint_as_float(w.y & 0xffff0000u); }
        const uint2 gw = p.gt[et];
        uint2 ow;
        ow.x = pk2(o[0] * inv * siluf(__uint_as_float(gw.x << 16)), o[1] * inv * siluf(__uint_as_float(gw.x & 0xffff0000u)));
        ow.y = pk2(o[2] * inv * siluf(__uint_as_float(gw.y << 16)), o[3] * inv * siluf(__uint_as_float(gw.y & 0xffff0000u)));
        *(uint2*)(proj + (size_t)t * NP + C_AG + h * 64 + e) = ow;
    }
}
__device__ __forceinline__ void moba_own_unit(GCtx& c, const Args& a, int h, int j) {
    OwnPre cur; own_prefetch(c, a, h, j, tile16_of(c.wave, 0), cur);
    { u32x4 kr[8], vr[8]; moba_load_kv(c, a, h, j, kr, vr); moba_store_kv(c, kr, vr, exp2f(-(float)(h + 1)) * 1.4426950408889634f); }
    gsync(c);
#pragma unroll 1
    for (int k = 0; k < 4; ++k) {
        UNIT_FENCE(c);
        OwnPre nxt; own_prefetch(c, a, h, j, tile16_of(c.wave, k < 3 ? k + 1 : 3), nxt);
        own_compute(c, a, h, j, tile16_of(c.wave, k), cur);
        cur = nxt;
    }
    gsync(c);
}

#define SCAN_TILE_EQ 4
#define SEL_STAGE_W 2
struct SelRun { int valid, pair, k0, k1, pnext; };
__device__ __forceinline__ SelRun sel_find_run(const LAS unsigned* pre, int p, int p1) {
    SelRun r; r.valid = 0; r.pair = 0; r.k0 = 0; r.k1 = 0; r.pnext = p1;
    while (p < p1) {
        int lo = 0, hi = 511;
        while (lo < hi) { const int mid = (lo + hi) >> 1; if (pre[mid] > (unsigned)p) hi = mid; else lo = mid + 1; }
        const int before = lo ? (int)pre[lo - 1] : 0, end = (int)pre[lo], tiles = end - before - SEL_STAGE_W;
        int k0 = p - before - SEL_STAGE_W; k0 = k0 < 0 ? 0 : k0;
        int k1 = p1 - before - SEL_STAGE_W; k1 = k1 > tiles ? tiles : k1;
        p = end < p1 ? end : p1;
        if (k1 > k0) { r.valid = 1; r.pair = lo; r.k0 = k0; r.k1 = k1; r.pnext = p; return r; }
    }
    return r;
}
__device__ __forceinline__ void moba_sel_prefix(const Ctx& c, const Args& a, int l) {
    LAS unsigned* pre = (LAS unsigned*)(c.lds + LDS_PRE);
    const unsigned* gcnt = (const unsigned*)(a.ws + WS_CTL) + CW_CNT(l);
    const unsigned cntp = __hip_atomic_load(gcnt + c.tid, __ATOMIC_RELAXED, __HIP_MEMORY_SCOPE_AGENT);
    unsigned v = cntp ? ((cntp + 63u) >> 6) + SEL_STAGE_W : 0u;
#pragma unroll
    for (int o = 1; o < 64; o <<= 1) { const unsigned nb = __shfl_up(v, o); if (c.lane >= o) v += nb; }
    if (c.lane == 63) pre[512 + c.wave] = v;
    __syncthreads();
    unsigned woff = 0;
    for (int w = 0; w < c.wave; ++w) woff += pre[512 + w];
    pre[c.tid] = v + woff;
    __syncthreads();
}
__device__ __forceinline__ void moba_sel_phase(GCtx& c, const Args& a, int l, int nscan) {
    const LAS unsigned* pre = (const LAS unsigned*)((LAS unsigned char*)0 + LDS_PRE);
    const bf16_t* proj = (const bf16_t*)(a.ws + WS_PROJ);
    const unsigned* gcnt = (const unsigned*)(a.ws + WS_CTL) + CW_CNT(l);
    const int TW = (int)pre[511];
    const int q = (TW + SCAN_TILE_EQ * nscan + c.ng - 1) / c.ng;
    int p0 = c.gg * q - SCAN_TILE_EQ * (c.gg < nscan ? c.gg : nscan), p1 = (c.gg + 1) * q - SCAN_TILE_EQ * (c.gg + 1 < nscan ? c.gg + 1 : nscan);
    p0 = p0 < 0 ? 0 : (p0 > TW ? TW : p0); p1 = p1 < 0 ? 0 : (p1 > TW ? TW : p1);
    const int i = c.lane & 15, g = c.lane >> 4;
    SelRun cur = sel_find_run(pre, p0, p1);
    if (cur.valid) { u32x4 kr[8], vr[8]; moba_load_kv(c, a, cur.pair >> 6, cur.pair & 63, kr, vr); moba_store_kv(c, kr, vr, exp2f(-(float)((cur.pair >> 6) + 1)) * 1.4426950408889634f); }
    gsync(c);
    while (cur.valid) {
        const SelRun nxt = sel_find_run(pre, cur.pnext, p1);
        u32x4 kr[8];
        if (nxt.valid) {
            const int hn = nxt.pair >> 6, nn = nxt.pair & 63;
#pragma unroll
            for (int q = 0; q < 8; ++q) { const int it = c.tid + q * GT, row = it >> 3, c16 = it & 7; kr[q] = *(const u32x4*)(proj + (size_t)(nn * 256 + row) * NP + hn * 64 + 8 * c16 + C_AK); }
        }
        const int h = cur.pair >> 6, n = cur.pair & 63;
        const float sl2 = exp2f(-(float)(h + 1)) * 1.4426950408889634f;
        const bf16x8 cfrag = moba_cfrag(sl2, c.lane);
        const unsigned cn = __hip_atomic_load(gcnt + cur.pair, __ATOMIC_RELAXED, __HIP_MEMORY_SCOPE_AGENT);
        const unsigned* list = (const unsigned*)(a.ws + WS_LIST) + (size_t)h * LIST_PER_HEAD + list_off(n);
        const unsigned ebase = (unsigned)(cur.k0 * 64 + c.wave * 16 + i);
        const unsigned efirst = (unsigned)(cur.k0 * 64);
        unsigned e_cur = ebase, e_nxt = ebase + 64u;
        unsigned ent_cur = list[e_cur < cn ? e_cur : efirst], ent_nxt = list[e_nxt < cn ? e_nxt : efirst];
        bf16x8 qf[2]; load_qf(proj + (size_t)(ent_cur >> 2) * NP + C_AQ + h * 64, qf, g);
        for (int k = cur.k0; k < cur.k1; ++k) {
            bf16x8 qn[2]; load_qf(proj + (size_t)(ent_nxt >> 2) * NP + C_AQ + h * 64, qn, g);
            const unsigned e_nn = e_nxt + 64u;
            const unsigned ent_nn = list[e_nn < cn ? e_nn : efirst];
            const bool valid = e_cur < cn;
            if (__any(valid)) moba_sel_wave(c, a, h, n, ent_cur, valid, qf, sl2, cfrag);
            e_cur = e_nxt; e_nxt = e_nn; ent_cur = ent_nxt; ent_nxt = ent_nn; qf[0] = qn[0]; qf[1] = qn[1];
        }
        gsync(c);
        if (nxt.valid) {
            const int hn = nxt.pair >> 6, nn = nxt.pair & 63;
            u32x4 vr[8];
#pragma unroll
            for (int q = 0; q < 8; ++q) { const int it = c.tid + q * GT, row = it >> 3, c16 = it & 7; vr[q] = *(const u32x4*)(proj + (size_t)(nn * 256 + row) * NP + hn * 64 + 8 * c16 + C_AV); }
            moba_store_kv(c, kr, vr, exp2f(-(float)(hn + 1)) * 1.4426950408889634f);
        }
        gsync(c);
        cur = nxt;
    }
}
__device__ __forceinline__ void phase_pb(const Ctx& c, const Args& a, int l) {
    const bool tail = c.bid < N_TAIL_WG;
    if (tail) gemm_tail(c, a);
    if (l >= 1) convert_w_out(c, a, l);
    __syncthreads();
    GCtx g = make_group(c);
    const int gi = tail ? g.gg : g.gg - 2 * N_TAIL_WG;
    const int nu = tail ? 1 : (gi >= 128 && gi < 256 ? 5 : 4), us = g.ng - 2 * N_TAIL_WG;
    for (int k = 0; k < nu; ++k) {
        const int u = tail ? 1536 + gi : (k < 4 ? gi + k * us : 1664 + (gi - 128));
        UNIT_FENCE(g);
        if (u < 512) { PSUB_T0(c, 21); ml_x1_unit(g, a, l, u >> 7, u & 127); PSUB_T1(c, 21); }
        else if (u < 1536) { PSUB_T0(c, 22); moba_gate_unit(g, a, l, (u - 512) >> 7, (u - 512) & 127); PSUB_T1(c, 22); }
        else { PSUB_T0(c, 20); ret_x1_unit(g, a, (u - 1536) >> 6, (u - 1536) & 63); PSUB_T1(c, 20); }
    }
}
#define N_RET_SCAN 64
#define N_ML_SCAN 68
__device__ __forceinline__ void phase_pc(const Ctx& c, const Args& a, int l) {
    moba_sel_prefix(c, a, l);
    GCtx g = make_group(c);
    if (g.gg < N_RET_SCAN) ret_scan_unit(g, a, g.gg >> 4, g.gg & 15);
    else if (g.gg < N_RET_SCAN + N_ML_SCAN) ml_scan_unit(g, a, (g.gg - N_RET_SCAN) / 17, (g.gg - N_RET_SCAN) % 17);
    UNIT_FENCE(g);
    PSUB_T0(c, 5);
    moba_sel_phase(g, a, l, N_RET_SCAN + N_ML_SCAN);
    PSUB_T1(c, 5);
}
__device__ __forceinline__ void phase_pd(const Ctx& c, const Args& a, int l) {
    PSUB_T0(c, 13);
    GCtx g = make_group(c);
    UNIT_FENCE(g);
    PSUB_T0(c, 10); moba_own_unit(g, a, g.gg >> 6, g.gg & 63); PSUB_T1(c, 10);
    UNIT_FENCE(g);
    if (g.gg < 256) { PSUB_T0(c, 11); ret_x3_unit(g, a, l, g.gg >> 6, g.gg & 63); PSUB_T1(c, 11); }
    else {
        PSUB_T0(c, 12);
        { const int u = 2 * (g.gg - 256); UNIT_FENCE(g); ml_x3_unit(g, a, l, u >> 7, u & 127); }
        PSUB_T1(c, 12);
    }
    PSUB_T1(c, 13);
    PSUB_T0(c, 14);
    if (l + 1 < DEPTH) { __syncthreads(); convert_w_in(c, a, l + 1); }
    PSUB_T1(c, 14);
}
__global__ void __launch_bounds__(NTHREADS, 2) mk(Args args) {
    extern __shared__ __attribute__((aligned(16))) unsigned char lds_raw[];
    LAS unsigned char* lds = (LAS unsigned char*)lds_raw;
    const bool t0_ = threadIdx.x == 0;
    const int wave0_ = __builtin_amdgcn_readfirstlane((int)threadIdx.x >> 6);
    volatile LAS unsigned* MISC = (volatile LAS unsigned*)(lds + LDS_CTL_OFF);
    if (threadIdx.x < 64) MISC[threadIdx.x] = 0u;
    __syncthreads();
    XcdBarrier bar; bar.bar = (unsigned*)(args.ws + WS_CTL) + CW_BAR; bar.x = 0; bar.st = MISC + 8;
    const bool multi = (args.ph_hi - args.ph_lo) > 1;
    if (multi) bar = xcd_barrier_post((unsigned*)(args.ws + WS_CTL) + CW_BAR, MISC + 8);
#ifdef PROBE_SEL
    unsigned long long pr_acc = 0ull, pr_t0 = __builtin_amdgcn_s_memrealtime();
#endif
    int ph0 = args.ph_lo;
    if (ph0 == 0) {
        Ctx c; { int tid_; asm volatile("v_mbcnt_lo_u32_b32 %0, -1, 0\n\tv_mbcnt_hi_u32_b32 %0, -1, %0" : "=v"(tid_)); tid_ += wave0_ * 64;     c.lds = lds; c.tid = tid_; c.lane = c.tid & 63; c.wave = __builtin_amdgcn_readfirstlane(c.tid >> 6); c.G = gridDim.x; c.bid = blockIdx.x; }
        PSUB_T0(c, 50);
        phase_p0(c, args);
        PSUB_T1(c, 50);
        PSUB_T0(c, 51);
        if (1 < args.ph_hi) xcd_barrier(bar, t0_);
        PSUB_T1(c, 51);
        ph0 = 1;
    }
    for (int ph = ph0; ph < args.ph_hi; ++ph) {
#define MK_CTX() Ctx c; { int tid_; asm volatile("v_mbcnt_lo_u32_b32 %0, -1, 0\n\tv_mbcnt_hi_u32_b32 %0, -1, %0" : "=v"(tid_)); tid_ += wave0_ * 64;     c.lds = lds; c.tid = tid_; c.lane = c.tid & 63; c.wave = __builtin_amdgcn_readfirstlane(c.tid >> 6); c.G = gridDim.x; c.bid = blockIdx.x; }
        if (ph < 21) {
            const int l = (ph - 1) / 5, s = (ph - 1) % 5;
            if (s == 0) { MK_CTX(); phase_pa(c, args, l); }
            else if (s == 1) { MK_CTX(); phase_pb(c, args, l); }
            else if (s == 2) { MK_CTX(); phase_pc(c, args, l); }
            else if (s == 3) { MK_CTX(); phase_pd(c, args, l); }
            else if (s == 4) { MK_CTX(); phase_pe(c, args, l); }
        }
        else if (ph == 21) { MK_CTX(); phase_final(c, args); }
        if (ph + 1 < args.ph_hi && !(ph < 16 && (ph % 5) == 0)) xcd_barrier(bar, t0_);
#ifdef PROBE_SEL
        { const unsigned long long t1 = __builtin_amdgcn_s_memrealtime(); if (PROBE_SEL(ph)) pr_acc += t1 - pr_t0; pr_t0 = t1; }
#endif
    }
#ifdef PROBE_SUB
    if (blockIdx.x == PROBE_BLOCK && threadIdx.x == 0) { const unsigned long long acc_ = ((volatile LAS unsigned long long*)(lds + LDS_CTL_OFF + 128))[1];
        const unsigned long long t_end = __builtin_amdgcn_s_memrealtime() + (unsigned long long)PROBE_K * acc_; while (__builtin_amdgcn_s_memrealtime() < t_end) __builtin_amdgcn_s_sleep(32); }
#endif
#ifdef PROBE_SEL
    if (blockIdx.x == 0) { const unsigned long long t_end = __builtin_amdgcn_s_memrealtime() + (unsigned long long)PROBE_K * pr_acc; while (__builtin_amdgcn_s_memrealtime() < t_end) __builtin_amdgcn_s_sleep(32); }
#endif
}

extern "C" void kernel_launch(void* const* d_in, const int* in_sizes, int n_in, void* d_out, int out_size, void* d_ws, size_t ws_size, hipStream_t stream) {
    static bool attr = false;
    if (!attr) { (void)hipFuncSetAttribute((const void*)mk, hipFuncAttributeMaxDynamicSharedMemorySize, LDS_BYTES); attr = true; }
    Args a{};
    a.x = (const float*)d_in[0]; a.norm_w = (const float*)d_in[1]; a.w_in = (const float*)d_in[2]; a.conv_w = (const float*)d_in[3]; a.conv_b = (const float*)d_in[4];
    a.gate_bias = (const float*)d_in[5]; a.ret_nw = (const float*)d_in[6]; a.ml_nw = (const float*)d_in[7]; a.w_out = (const float*)d_in[8]; a.final_nw = (const float*)d_in[9];
    a.out = (float*)d_out; a.ws = (unsigned char*)d_ws;
    unsigned char* ws = (unsigned char*)d_ws;
    (void)hipMemsetAsync(ws + WS_CTL, 0, CTL_BYTES, stream);
    const int G = 256;
    auto run = [&](int lo, int hi) { a.ph_lo = lo; a.ph_hi = hi; hipLaunchKernelGGL(mk, dim3(G), dim3(NTHREADS), LDS_BYTES, stream, a); };
    run(0, 22);
}
```
